# Optimizing an MI355X kernel written in HIP

```python
import math
import jax, jax.numpy as jnp
from jax import lax
import numpy as np

D_MODEL = 1024
BATCH = 1
SEQ = 16384
DEPTH = 2

MIX_WIDTH = D_MODEL
HG_WIDTH = D_MODEL // 4
HG_HEAD_DIM = 64
HG_HEADS = HG_WIDTH // HG_HEAD_DIM
HG_CHUNK = 128
S5_WIDTH = D_MODEL // 4
S5_GROUP = 16
S5_GROUPS = S5_WIDTH // S5_GROUP
S5_STATE = 64
S5_MIN_NEG = 1e-4
DA_WIDTH = D_MODEL // 2
DA_HEAD_DIM = 64
DA_HEADS = DA_WIDTH // (2 * DA_HEAD_DIM)
DA_QK_WIDTH = DA_HEADS * 2 * DA_HEAD_DIM
DA_BLOCK = 128
ROPE_THETA = 10000.0
D_FF = 4 * D_MODEL
EPS = 1e-6
IN_SIZES = (HG_WIDTH, HG_WIDTH, HG_WIDTH, HG_WIDTH, S5_WIDTH, DA_QK_WIDTH, DA_QK_WIDTH, DA_WIDTH)
IN_COLS = 4 * HG_WIDTH + S5_WIDTH + 2 * DA_QK_WIDTH + DA_WIDTH

kernel_name = "hymba_style_hgrn2_s5_diffattn_hybrid"


def rms_norm(x, gain):
    xf = x.astype(jnp.float32)
    var = jnp.mean(xf * xf, axis=-1, keepdims=True)
    return (xf * lax.rsqrt(var + EPS) * gain.astype(jnp.float32)).astype(x.dtype)


def hgrn2_mixer(q, f, i, g, lb, g_norm_gain):
    B, L, _ = q.shape
    nc = L // HG_CHUNK

    def heads(t):
        return t.astype(jnp.float32).reshape(B, nc, HG_CHUNK, HG_HEADS, HG_HEAD_DIM).transpose(1, 0, 3, 2, 4)

    lbf = jnp.clip(lb.astype(jnp.float32), 0.0, 1.0).reshape(1, 1, HG_HEADS, 1, HG_HEAD_DIM)
    qh = jax.nn.silu(heads(q))
    fr = heads(f)
    log_f = jnp.logaddexp(jnp.log(lbf), jnp.log1p(-lbf) + jax.nn.log_sigmoid(fr))
    kh = (1.0 - lbf) * jax.nn.sigmoid(-fr)
    vh = heads(i)
    causal = jnp.tril(jnp.ones((HG_CHUNK, HG_CHUNK), dtype=bool))[:, :, None]

    def step(S, inp):
        qc, kc, vc, lfc = inp
        b = jnp.cumsum(lfc, axis=2)
        o_inter = jnp.einsum('bhtk,bhkv->bhtv', qc * jnp.exp(b), S)
        rel = b[:, :, :, None, :] - b[:, :, None, :, :]
        decay = jnp.exp(jnp.where(causal, rel, -jnp.inf))
        scores = jnp.einsum('bhtk,bhsk,bhtsk->bhts', qc, kc, decay)
        o_intra = jnp.einsum('bhts,bhsv->bhtv', scores, vc)
        b_last = b[:, :, -1:, :]
        S_new = jnp.exp(b_last[:, :, 0, :])[..., None] * S + jnp.einsum(
            'bhsk,bhsv->bhkv', kc * jnp.exp(b_last - b), vc)
        return S_new, o_inter + o_intra

    S0 = jnp.zeros((B, HG_HEADS, HG_HEAD_DIM, HG_HEAD_DIM), jnp.float32)
    _, o = lax.scan(step, S0, (qh, kh, vh, log_f))
    o = o.transpose(1, 0, 3, 2, 4).reshape(B, L, HG_HEADS, HG_HEAD_DIM)
    gate = jax.nn.silu(g.astype(jnp.float32).reshape(B, L, HG_HEADS, HG_HEAD_DIM))
    o = rms_norm(o, g_norm_gain) * gate
    return o.reshape(B, L, HG_WIDTH)


def s5_mixer(u, a_re, a_im, log_dt, b_re, b_im, c_re, c_im, d_skip, w_glu, out_gain):
    B, L, _ = u.shape
    f32 = jnp.float32
    uf = u.astype(f32).reshape(B, L, S5_GROUPS, S5_GROUP)
    lam = lax.complex(jnp.minimum(a_re.astype(f32), -S5_MIN_NEG), a_im.astype(f32))
    dt = jnp.exp(log_dt.astype(f32))
    a_bar = jnp.exp(lam * dt)
    b_scale = (a_bar - 1.0) / lam
    b_bar = lax.complex(b_re.astype(f32), b_im.astype(f32)) * b_scale[..., None]
    bu = jnp.einsum('blgh,gph->blgp', uf.astype(jnp.complex64), b_bar)
    a_seq = jnp.broadcast_to(a_bar, bu.shape)

    def combine(left, right):
        a_l, b_l = left
        a_r, b_r = right
        return a_r * a_l, a_r * b_l + b_r

    _, states = lax.associative_scan(combine, (a_seq, bu), axis=1)
    c_mat = lax.complex(c_re.astype(f32), c_im.astype(f32))
    y = jnp.einsum('blgp,ghp->blgh', states, c_mat).real + d_skip.astype(f32) * uf
    y = jax.nn.gelu(y.reshape(B, L, S5_WIDTH))
    y = y * jax.nn.sigmoid(y @ w_glu.astype(f32))
    return rms_norm(y, out_gain)


def rope(t, cos, sin):
    t1, t2 = jnp.split(t, 2, axis=-1)
    return jnp.concatenate([t1 * cos - t2 * sin, t2 * cos + t1 * sin], axis=-1)


def diff_attention(q, k, v, positions, q_gain, k_gain, lq1, lk1, lq2, lk2, subln_gain, lambda_init):
    B, L, _ = q.shape
    f32 = jnp.float32
    q = q.astype(f32).reshape(B, L, DA_HEADS, 2, DA_HEAD_DIM)
    k = k.astype(f32).reshape(B, L, DA_HEADS, 2, DA_HEAD_DIM)
    v = v.astype(f32).reshape(B, L, DA_HEADS, 2 * DA_HEAD_DIM)
    q = rms_norm(q, q_gain)
    k = rms_norm(k, k_gain)
    inv_freq = ROPE_THETA ** (-jnp.arange(0, DA_HEAD_DIM, 2, dtype=f32) / DA_HEAD_DIM)
    ang = positions.astype(f32)[..., None] * inv_freq
    cos = jnp.cos(ang)[:, :, None, None, :]
    sin = jnp.sin(ang)[:, :, None, None, :]
    q = rope(q, cos, sin) * (DA_HEAD_DIM ** -0.5)
    k = rope(k, cos, sin)
    lam = (jnp.exp(jnp.sum(lq1.astype(f32) * lk1.astype(f32)))
           - jnp.exp(jnp.sum(lq2.astype(f32) * lk2.astype(f32))) + lambda_init)
    kt = k.transpose(0, 2, 3, 1, 4)
    vt = v.transpose(0, 2, 1, 3)
    nb = L // DA_BLOCK
    qb = q.reshape(B, nb, DA_BLOCK, DA_HEADS, 2, DA_HEAD_DIM).transpose(1, 0, 3, 4, 2, 5)
    pb = positions.reshape(B, nb, DA_BLOCK).transpose(1, 0, 2)

    def block(args):
        qblk, pos_q = args
        s = jnp.einsum('bhcqd,bhckd->bhcqk', qblk, kt)
        mask = positions[:, None, None, None, :] <= pos_q[:, None, None, :, None]
        p = jax.nn.softmax(jnp.where(mask, s, -jnp.inf), axis=-1)
        w = p[:, :, 0] - lam * p[:, :, 1]
        return jnp.einsum('bhqk,bhkv->bhqv', w, vt)

    o = lax.map(block, (qb, pb))
    o = o.transpose(1, 0, 3, 2, 4).reshape(B, L, DA_HEADS, 2 * DA_HEAD_DIM)
    o = rms_norm(o, subln_gain) * (1.0 - lambda_init)
    return o.reshape(B, L, DA_WIDTH)


def setup_inputs(seed: int = 0) -> dict:
    key = jax.random.key(seed)
    ks = jax.random.split(key, 32)
    f32 = jnp.float32
    nrm = lambda k, shape, s: jax.random.normal(k, shape, f32) * s
    gain = lambda k, shape: 1.0 + 0.02 * jax.random.normal(k, shape, f32)
    n_idx = jnp.arange(S5_STATE, dtype=f32)
    return {
        "x": jax.random.normal(ks[0], (BATCH, SEQ, D_MODEL), f32),
        "positions": jnp.broadcast_to(jnp.arange(SEQ, dtype=jnp.int32), (BATCH, SEQ)),
        "hgrn_lower_bounds": nrm(ks[1], (DEPTH, HG_WIDTH), 0.1),
        "attn_norm_gain": gain(ks[2], (DEPTH, D_MODEL)),
        "w_in": nrm(ks[3], (DEPTH, D_MODEL, IN_COLS), D_MODEL ** -0.5),
        "hg_norm_gain": gain(ks[4], (DEPTH, HG_HEAD_DIM)),
        "s5_a_re": -0.5 + nrm(ks[5], (DEPTH, S5_GROUPS, S5_STATE), 0.01),
        "s5_a_im": math.pi * n_idx + nrm(ks[6], (DEPTH, S5_GROUPS, S5_STATE), 0.01),
        "s5_log_dt": jax.random.uniform(ks[7], (DEPTH, S5_GROUPS, S5_STATE), f32,
                                        math.log(1e-3), math.log(1e-1)),
        "s5_b_re": nrm(ks[8], (DEPTH, S5_GROUPS, S5_STATE, S5_GROUP), (2 * S5_GROUP) ** -0.5),
        "s5_b_im": nrm(ks[9], (DEPTH, S5_GROUPS, S5_STATE, S5_GROUP), (2 * S5_GROUP) ** -0.5),
        "s5_c_re": nrm(ks[10], (DEPTH, S5_GROUPS, S5_GROUP, S5_STATE), S5_STATE ** -0.5),
        "s5_c_im": nrm(ks[11], (DEPTH, S5_GROUPS, S5_GROUP, S5_STATE), S5_STATE ** -0.5),
        "s5_d": nrm(ks[12], (DEPTH, S5_GROUPS, S5_GROUP), 1.0),
        "s5_w_glu": nrm(ks[13], (DEPTH, S5_WIDTH, S5_WIDTH), S5_WIDTH ** -0.5),
        "s5_norm_gain": gain(ks[14], (DEPTH, S5_WIDTH)),
        "da_q_norm_gain": gain(ks[15], (DEPTH, DA_HEAD_DIM)),
        "da_k_norm_gain": gain(ks[16], (DEPTH, DA_HEAD_DIM)),
        "da_lambda_q1": nrm(ks[17], (DEPTH, DA_HEAD_DIM), 0.1),
        "da_lambda_k1": nrm(ks[18], (DEPTH, DA_HEAD_DIM), 0.1),
        "da_lambda_q2": nrm(ks[19], (DEPTH, DA_HEAD_DIM), 0.1),
        "da_lambda_k2": nrm(ks[20], (DEPTH, DA_HEAD_DIM), 0.1),
        "da_subln_gain": gain(ks[21], (DEPTH, 2 * DA_HEAD_DIM)),
        "w_out": nrm(ks[22], (DEPTH, MIX_WIDTH, D_MODEL), MIX_WIDTH ** -0.5),
        "mlp_norm_gain": gain(ks[23], (DEPTH, D_MODEL)),
        "w_mlp_up": nrm(ks[24], (DEPTH, D_MODEL, D_FF), D_MODEL ** -0.5),
        "w_mlp_down": nrm(ks[25], (DEPTH, D_FF, D_MODEL), D_FF ** -0.5),
    }


def reference(x, positions, hgrn_lower_bounds, attn_norm_gain, w_in, hg_norm_gain,
              s5_a_re, s5_a_im, s5_log_dt, s5_b_re, s5_b_im, s5_c_re, s5_c_im, s5_d,
              s5_w_glu, s5_norm_gain, da_q_norm_gain, da_k_norm_gain, da_lambda_q1,
              da_lambda_k1, da_lambda_q2, da_lambda_k2, da_subln_gain, w_out,
              mlp_norm_gain, w_mlp_up, w_mlp_down):
    lb_all = jnp.cumsum(jax.nn.softmax(hgrn_lower_bounds.astype(jnp.float32), axis=0), axis=0)
    lb_all = lb_all - lb_all[0]
    split_points = [int(v) for v in np.cumsum(IN_SIZES)[:-1]]
    for l in range(DEPTH):
        lambda_init = 0.8 - 0.6 * math.exp(-0.3 * l)
        h = rms_norm(x, attn_norm_gain[l])
        proj = h @ w_in[l]
        hq, hf, hi, hg, su, dq, dk, dv = jnp.split(proj, split_points, axis=-1)
        o_a = hgrn2_mixer(hq, hf, hi, hg, lb_all[l], hg_norm_gain[l])
        o_b = s5_mixer(su, s5_a_re[l], s5_a_im[l], s5_log_dt[l], s5_b_re[l], s5_b_im[l],
                       s5_c_re[l], s5_c_im[l], s5_d[l], s5_w_glu[l], s5_norm_gain[l])
        o_c = diff_attention(dq, dk, dv, positions, da_q_norm_gain[l], da_k_norm_gain[l],
                             da_lambda_q1[l], da_lambda_k1[l], da_lambda_q2[l], da_lambda_k2[l],
                             da_subln_gain[l], lambda_init)
        mixed = jnp.concatenate([o_a, o_b, o_c], axis=-1).astype(x.dtype)
        x = x + mixed @ w_out[l]
        h = rms_norm(x, mlp_norm_gain[l])
        x = x + jnp.square(jax.nn.relu(h @ w_mlp_up[l])) @ w_mlp_down[l]
    return x
```

```cpp
#include <hip/hip_runtime.h>
#include <hip/hip_cooperative_groups.h>
#include <cstdio>
#include <cstdint>
namespace cg = cooperative_groups;

__shared__ unsigned g_wtab[64];
__device__ __forceinline__ unsigned hw_slot() { return (unsigned)__builtin_amdgcn_s_getreg((6 << 11) | 4) & 63u; }
__shared__ unsigned g_simdcnt[4];
__device__ __forceinline__ int my_stagger() { return (__builtin_amdgcn_readfirstlane((int)((volatile __attribute__((address_space(3))) unsigned*)g_wtab)[hw_slot()]) >> 8) & 1; }
__device__ __forceinline__ int my_tid() {
  int lane = (int)__builtin_amdgcn_mbcnt_hi(~0u, __builtin_amdgcn_mbcnt_lo(~0u, 0u)); asm volatile("" : "+v"(lane));
  const int wave = __builtin_amdgcn_readfirstlane((int)((volatile __attribute__((address_space(3))) unsigned*)g_wtab)[hw_slot()]) & 0xff;
  return wave * 64 + lane;
}
#ifndef PH
#define PH 0x1fff
#endif
namespace pg8 {
#define PG8_LAS __attribute__((address_space(3)))
typedef unsigned short bf16_t;
typedef short bf16x8 __attribute__((ext_vector_type(8)));
typedef float f32x4 __attribute__((ext_vector_type(4)));
typedef unsigned u32x4 __attribute__((ext_vector_type(4)));
constexpr int BM = 256, BK = 64, HALF = 128, HTB = HALF * BK * 2  , STAGE_BYTES = 8 * HTB, NXCD = 8, WGM = 8;

__host__ __device__ __forceinline__ int lds_byte(int r, int c) { const int st = (r >> 4) * 2 + (c >> 5), rr = r & 15, cc = c & 31, ob = rr * 64 + cc * 2; return st * 1024 + (ob ^ (((ob >> 9) & 1) << 5)); }
__host__ __device__ __forceinline__ void stage_rc(int b, int& R, int& C) { const int st = b / 1024, sb = b % 1024, swz = sb ^ (((sb >> 9) & 1) << 5); R = (st >> 1) * 16 + swz / 64; C = (st & 1) * 32 + (swz % 64) / 2; }
__host__ __device__ __forceinline__ int perm32(int rho) { const int n = rho >> 4, i = rho & 15; return 8 * (i >> 2) + 4 * n + (i & 3); }

struct Unit { int pm, pn; };
struct Gemm { const bf16_t* A; const bf16_t* Bt; int M, N, K; };

struct StaticOrder {
    int nM, nN, nwg, G, c;
    __host__ __device__ void init(int M, int N, int G_, int c_) { nM = M / BM; nN = N / BM; nwg = nM * nN; G = G_; c = c_; }
    __host__ __device__ bool next(int i, Unit& u) const {
        const long L = (long)i * G + c; if (L >= nwg) return false;
        int wgid = (int)L; { const int q = nwg / NXCD, r = nwg % NXCD, xcd = wgid % NXCD, off = wgid / NXCD; wgid = (xcd < r ? xcd * (q + 1) : r * (q + 1) + (xcd - r) * q) + off; }
        const int nig = WGM * nN, gid = wgid / nig, fm = gid * WGM, gsz = (nM - fm) < WGM ? (nM - fm) : WGM;
        u.pm = fm + ((wgid % nig) % gsz); u.pn = (wgid % nig) / gsz; return true;
    }
    __device__ __forceinline__ void a_ready(const Unit&) const {}
    __device__ __forceinline__ void done(const Unit&) const {}
};

template <class Epi, class Sched, bool ALIGN_EPI = false, bool SP2 = false>
__device__ __forceinline__ void gemm_phase(PG8_LAS unsigned char* lds, const Gemm g, const Sched& S, const Epi& E) {
    int tid_ = my_tid();
    const int tid = tid_, wid = __builtin_amdgcn_readfirstlane(tid >> 6), lane = tid & 63, wr = wid >> 2, wc = wid & 3, fr = lane & 15, fq = lane >> 4;
    const int K = g.K, nt = K / BK;
    unsigned voffA[2], voffB[2];
#pragma unroll
    for (int i = 0; i < 2; ++i) { int R, C; stage_rc(tid * 16 + i * 8192, R, C); const int Rb = Epi::PERM ? ((R & ~31) + perm32(R & 31)) : R;
        voffA[i] = (unsigned)(R * K + C) * 2u; voffB[i] = (unsigned)(Rb * K + C) * 2u; }
    const size_t kstep = (size_t)(BK * 2);
    const size_t hstep = (size_t)HALF * K * 2;
    const size_t tstep = 2 * hstep;
    const unsigned ldsw = (unsigned)wid * 1024u;
    const int aoff = lds_byte(wr * 64 + fr, fq * 8), boff = lds_byte(wc * 32 + fr, fq * 8);
#define PG8_SA(b, h) (((b) * 2 + (h)) * HTB)
#define PG8_SB(b, h) ((4 + (b) * 2 + (h)) * HTB)
    const __amdgpu_buffer_rsrc_t rsA_ = __builtin_amdgcn_make_buffer_rsrc((void*)g.A, 0, 0x7fffffff, 0x00020000);
    const __amdgpu_buffer_rsrc_t rsB_ = __builtin_amdgcn_make_buffer_rsrc((void*)g.Bt, 0, 0x7fffffff, 0x00020000);
#define PG8_STAGE(bufoff, gbase, voff) do { const bool isA_ = ((voff) == voffA); const unsigned so_ = (unsigned)((const char*)(gbase) - (isA_ ? (const char*)g.A : (const char*)g.Bt)); \
        _Pragma("unroll") for (int _i = 0; _i < 2; ++_i) { if (isA_) __builtin_amdgcn_raw_ptr_buffer_load_lds(rsA_, (PG8_LAS unsigned*)(lds + (bufoff) + ldsw + _i * 8192), 16, (voff)[_i], so_, 0, 0); \
          else __builtin_amdgcn_raw_ptr_buffer_load_lds(rsB_, (PG8_LAS unsigned*)(lds + (bufoff) + ldsw + _i * 8192), 16, (voff)[_i], so_, 0, 0); } } while (0)
#define PG8_LDA(dst, b, h) do { _Pragma("unroll") for (int m = 0; m < 4; ++m) _Pragma("unroll") for (int k = 0; k < 2; ++k) dst[m][k] = *(const PG8_LAS bf16x8*)(lds + PG8_SA(b, h) + aoff + m * 2048 + k * 1024); } while (0)
#define PG8_LDB(dst, b, h) do { _Pragma("unroll") for (int n = 0; n < 2; ++n) _Pragma("unroll") for (int k = 0; k < 2; ++k) dst[n][k] = *(const PG8_LAS bf16x8*)(lds + PG8_SB(b, h) + boff + n * 2048 + k * 1024); } while (0)
#define PG8_MMA(ai, bj, At, Bt) do { __builtin_amdgcn_s_setprio(1); _Pragma("unroll") for (int m = 0; m < 4; ++m) _Pragma("unroll") for (int n = 0; n < 2; ++n) _Pragma("unroll") for (int k = 0; k < 2; ++k) \
        acc[ai][bj][m][n] = __builtin_amdgcn_mfma_f32_16x16x32_bf16(Bt[n][k], At[m][k], acc[ai][bj][m][n], 0, 0, 0); __builtin_amdgcn_s_setprio(0); } while (0)
#define PG8_WAIT_V(n) asm volatile("s_waitcnt vmcnt(" #n ")" ::: "memory")
#define PG8_WAIT_L(n) asm volatile("s_waitcnt lgkmcnt(" #n ")" ::: "memory")
#define PG8_BAR __builtin_amdgcn_s_barrier()
#define PG8_SCHED __builtin_amdgcn_sched_barrier(0)
    Unit cur, nxt; int ui = 0;
    if (!S.next(0, cur)) return;
    f32x4 acc[2][2][4][2];
#pragma unroll
    for (int a = 0; a < 2; ++a)
#pragma unroll
        for (int b = 0; b < 2; ++b)
#pragma unroll
            for (int m = 0; m < 4; ++m)
#pragma unroll
                for (int n = 0; n < 2; ++n) acc[a][b][m][n] = (f32x4){0.f, 0.f, 0.f, 0.f};
    bf16x8 At[4][2], B0[2][2], B1[2][2];
    const char* cA = (const char*)g.A + (size_t)cur.pm * tstep; const char* cB = (const char*)g.Bt + (size_t)cur.pn * tstep;
    S.a_ready(cur);
    if constexpr (SP2) {
        PG8_STAGE(PG8_SB(0, 0), cB, voffB); PG8_STAGE(PG8_SB(0, 1), cB + hstep, voffB); PG8_STAGE(PG8_SA(0, 0), cA, voffA); PG8_STAGE(PG8_SA(0, 1), cA + hstep, voffA);
        if (wr == 1) PG8_BAR;
        PG8_WAIT_V(2); PG8_BAR;
        PG8_STAGE(PG8_SB(1, 0), cB + kstep, voffB); PG8_STAGE(PG8_SA(1, 0), cA + kstep, voffA); PG8_STAGE(PG8_SB(1, 1), cB + hstep + kstep, voffB);
        PG8_WAIT_V(6); PG8_BAR;
    } else {
        PG8_STAGE(PG8_SB(0, 0), cB, voffB); PG8_STAGE(PG8_SA(0, 0), cA, voffA); PG8_STAGE(PG8_SB(0, 1), cB + hstep, voffB); PG8_STAGE(PG8_SA(0, 1), cA + hstep, voffA);
        if (wr == 1) PG8_BAR;
        PG8_WAIT_V(4); PG8_BAR;
        PG8_STAGE(PG8_SB(1, 0), cB + kstep, voffB); PG8_STAGE(PG8_SA(1, 0), cA + kstep, voffA); PG8_STAGE(PG8_SB(1, 1), cB + hstep + kstep, voffB);
        PG8_WAIT_V(6); PG8_BAR;
    }
    for (;;) {
        const bool has_next = S.next(ui + 1, nxt);
        const char* nA = has_next ? (const char*)g.A + (size_t)nxt.pm * tstep : cA; const char* nB = has_next ? (const char*)g.Bt + (size_t)nxt.pn * tstep : cB;
        for (int t = 0; t < nt; t += 2) {
            const bool last = (t == nt - 2);
            const char* a1 = cA + (size_t)(t + 1) * kstep;
            const char* a2 = last ? nA : cA + (size_t)(t + 2) * kstep; const char* b2 = last ? nB : cB + (size_t)(t + 2) * kstep;
            const char* a3 = a2 + kstep; const char* b3 = b2 + kstep;
            if (last && has_next) S.a_ready(nxt);
            if constexpr (SP2) {
            PG8_LDB(B0, 0, 0); PG8_LDB(B1, 0, 1); PG8_SCHED; PG8_LDA(At, 0, 0); PG8_STAGE(PG8_SA(1, 1), a1 + hstep, voffA);
            PG8_WAIT_V(8); PG8_WAIT_L(0); PG8_BAR; PG8_MMA(0, 0, At, B0); PG8_MMA(0, 1, At, B1); PG8_BAR; PG8_SCHED;
            PG8_LDA(At, 0, 1); PG8_STAGE(PG8_SB(0, 0), b2, voffB); PG8_STAGE(PG8_SB(0, 1), b2 + hstep, voffB); PG8_STAGE(PG8_SA(0, 0), a2, voffA);
            PG8_WAIT_V(8); PG8_WAIT_L(0); PG8_BAR; PG8_MMA(1, 0, At, B0); PG8_MMA(1, 1, At, B1); PG8_BAR; PG8_SCHED;
            PG8_LDB(B0, 1, 0); PG8_LDB(B1, 1, 1); PG8_SCHED; PG8_LDA(At, 1, 0); PG8_STAGE(PG8_SA(0, 1), a2 + hstep, voffA);
            PG8_WAIT_V(8); PG8_WAIT_L(0); PG8_BAR; PG8_MMA(0, 0, At, B0); PG8_MMA(0, 1, At, B1); PG8_BAR; PG8_SCHED;
            PG8_LDA(At, 1, 1); PG8_STAGE(PG8_SB(1, 0), b3, voffB); PG8_STAGE(PG8_SB(1, 1), b3 + hstep, voffB); PG8_STAGE(PG8_SA(1, 0), a3, voffA);
            PG8_WAIT_V(8); PG8_WAIT_L(0); PG8_BAR; PG8_MMA(1, 0, At, B0); PG8_MMA(1, 1, At, B1); PG8_BAR; PG8_SCHED;
            } else {
            PG8_LDB(B0, 0, 0); PG8_SCHED; PG8_LDA(At, 0, 0); PG8_STAGE(PG8_SA(1, 1), a1 + hstep, voffA);
            PG8_WAIT_L(8); PG8_BAR; PG8_WAIT_L(0); PG8_MMA(0, 0, At, B0); PG8_BAR; PG8_SCHED;
            PG8_LDB(B1, 0, 1); PG8_STAGE(PG8_SB(0, 0), b2, voffB);
            PG8_BAR; PG8_WAIT_L(0); PG8_MMA(0, 1, At, B1); PG8_BAR;
            PG8_LDA(At, 0, 1); PG8_STAGE(PG8_SA(0, 0), a2, voffA);
            PG8_BAR; PG8_WAIT_L(0); PG8_MMA(1, 0, At, B0); PG8_BAR; PG8_SCHED;
            PG8_STAGE(PG8_SB(0, 1), b2 + hstep, voffB);
            PG8_WAIT_V(6); PG8_BAR; PG8_MMA(1, 1, At, B1); PG8_BAR;
            PG8_LDB(B0, 1, 0); PG8_SCHED; PG8_LDA(At, 1, 0); PG8_STAGE(PG8_SA(0, 1), a2 + hstep, voffA);
            PG8_WAIT_L(8); PG8_BAR; PG8_WAIT_L(0); PG8_MMA(0, 0, At, B0); PG8_BAR; PG8_SCHED;
            PG8_LDB(B1, 1, 1); PG8_STAGE(PG8_SB(1, 0), b3, voffB);
            PG8_BAR; PG8_WAIT_L(0); PG8_MMA(0, 1, At, B1); PG8_BAR;
            PG8_LDA(At, 1, 1); PG8_STAGE(PG8_SA(1, 0), a3, voffA);
            PG8_BAR; PG8_WAIT_L(0); PG8_MMA(1, 0, At, B0); PG8_BAR; PG8_SCHED;
            PG8_STAGE(PG8_SB(1, 1), b3 + hstep, voffB);
            PG8_WAIT_V(6); PG8_BAR; PG8_MMA(1, 1, At, B1); PG8_BAR;
            }
        }
        if constexpr (ALIGN_EPI) { if (wr == 0) PG8_BAR; }
        if constexpr (!Epi::AFTER_DRAIN) { E(acc, cur, wr, wc, fr, fq); S.done(cur); }
        if (!has_next) break;
#pragma unroll
        for (int a = 0; a < 2; ++a)
#pragma unroll
            for (int b = 0; b < 2; ++b)
#pragma unroll
                for (int m = 0; m < 4; ++m)
#pragma unroll
                    for (int n = 0; n < 2; ++n) acc[a][b][m][n] = (f32x4){0.f, 0.f, 0.f, 0.f};
        cur = nxt; cA = nA; cB = nB; ++ui;
        if constexpr (ALIGN_EPI) { if (wr == 1) PG8_BAR; }
    }
    PG8_WAIT_V(0);
    if constexpr (!ALIGN_EPI) { if (wr == 0) PG8_BAR; }
    PG8_BAR;
    if constexpr (Epi::AFTER_DRAIN) { E.fused(acc, cur, wr, wc, fr, fq, lds, wid, lane); S.done(cur); }
#undef PG8_SA
#undef PG8_SB
#undef PG8_STAGE
#undef PG8_LDA
#undef PG8_LDB
#undef PG8_MMA
#undef PG8_WAIT_V
#undef PG8_WAIT_L
#undef PG8_BAR
#undef PG8_SCHED
}
}

#define LAS __attribute__((address_space(3)))
#define DI __device__ __forceinline__
typedef unsigned short bf16_t;
typedef short bf16x8 __attribute__((ext_vector_type(8)));
typedef float f32x4 __attribute__((ext_vector_type(4)));
typedef float f32x2 __attribute__((ext_vector_type(2)));
typedef float f32x16 __attribute__((ext_vector_type(16)));
typedef unsigned u32x4 __attribute__((ext_vector_type(4)));
typedef unsigned u32x2 __attribute__((ext_vector_type(2)));
typedef __bf16 bf16x2v __attribute__((ext_vector_type(2)));

constexpr int M = 16384, DM = 1024, NIN = 2816, DFF = 4096, DEPTH = 2;
constexpr int PA_W = 1280, PB_W = 1536;
constexpr float EPS = 1e-6f, LOG2E = 1.4426950408889634f;
constexpr size_t MiB = 1048576;
constexpr size_t W_IN_OFF = 0, W_OUT_OFF = (size_t)NIN * DM * 2, W_UP_OFF = W_OUT_OFF + (size_t)DM * DM * 2, W_DOWN_OFF = W_UP_OFF + (size_t)DFF * DM * 2,
                 W_GLU_OFF = W_DOWN_OFF + (size_t)DM * DFF * 2, LAYER_W = W_GLU_OFF + 256 * 256 * 2;
static_assert(2 * LAYER_W <= 48 * MiB, "weights");
constexpr size_t WS_W = 0, WS_XN = 48 * MiB, WS_MIX = 80 * MiB, WS_PA = 112 * MiB, WS_PB = 192 * MiB, WS_H = 112 * MiB, WS_SMALL = 240 * MiB;
constexpr size_t WS_VT = WS_XN, WS_HU = WS_XN + 16 * MiB, WS_HSIN = WS_XN + 24 * MiB;
constexpr size_t WS_HD = WS_SMALL, WS_XE = WS_SMALL + 1 * MiB, WS_XIN = WS_SMALL + 3 * MiB, WS_BAR = WS_SMALL + 5 * MiB, WS_ROPE = WS_SMALL + 6 * MiB, WS_SSQ = WS_SMALL + 10 * MiB;
typedef unsigned long long u64_t;
constexpr float SSQ_SCALE = 1048576.f;
DI u64_t ssq_fix(float s) { return (u64_t)(s * SSQ_SCALE + 0.5f); }
DI float row_rstd(const u64_t* p) { const float s = (float)(*p) * (1.f / SSQ_SCALE); return 1.f / sqrtf(s * (1.f / 1024.f) + 1e-6f); }

struct Args { const void* in[27]; float* out; unsigned char* ws; };
struct Ctx { LAS unsigned char* lds; int tid, lane, wave, G, bid; };
typedef const __attribute__((address_space(4))) Args* CArgsP;
DI CArgsP get_args() { CArgsP p = (CArgsP)__builtin_amdgcn_kernarg_segment_ptr(); asm volatile("" : "+s"(p)); return p; }
DI Ctx mk_ctx(LAS unsigned char* lds) { Ctx c; int t = my_tid(); c.lds = lds; c.tid = t; c.lane = t & 63; c.wave = __builtin_amdgcn_readfirstlane(t >> 6); c.G = gridDim.x; c.bid = blockIdx.x; return c; }

DI unsigned pk2(float a, float b) { f32x2 v = {a, b}; bf16x2v r = __builtin_convertvector(v, bf16x2v); return __builtin_bit_cast(unsigned, r); }
DI bf16_t f2bf(float a) { return (bf16_t)(pk2(a, 0.f) & 0xffffu); }
DI float bf2f(bf16_t a) { return __uint_as_float(((unsigned)a) << 16); }
DI float wave_sum(float v) {
#pragma unroll
  for (int o = 1; o < 64; o <<= 1) v += __shfl_xor(v, o);
  return v;
}
DI float wave_max(float v) {
#pragma unroll
  for (int o = 1; o < 64; o <<= 1) v = fmaxf(v, __shfl_xor(v, o));
  return v;
}

DI float dpp_xor1(float v) { return __int_as_float(__builtin_amdgcn_mov_dpp(__float_as_int(v), 0xB1, 0xF, 0xF, true)); }
DI float dpp_xor2(float v) { return __int_as_float(__builtin_amdgcn_mov_dpp(__float_as_int(v), 0x4E, 0xF, 0xF, true)); }
DI float dpp_hmirror(float v) { return __int_as_float(__builtin_amdgcn_mov_dpp(__float_as_int(v), 0x141, 0xF, 0xF, true)); }
DI float sigmoidf_(float x) { return 1.f / (1.f + __expf(-x)); }
DI void wg_sync() { __syncthreads(); }


#define XB_TMO      128
#define XB_XCNT(j)  (256  + 64 * (j))
#define XB_XSUB(j)  (1280 + 64 * (j))
#define XB_XGEN(j)  (2304 + 64 * (j))
#define XB_TOP      3328
#define XB_TOPGEN   3392
#define XCD_BAR_WORDS 3456
#define XB_SPIN_CAP (1u << 18)
__device__ __forceinline__ unsigned xb_ld(unsigned* p)              { return __hip_atomic_load(p, __ATOMIC_RELAXED, __HIP_MEMORY_SCOPE_AGENT); }
__device__ __forceinline__ unsigned xb_add(unsigned* p, unsigned v) { return __hip_atomic_fetch_add(p, v, __ATOMIC_RELAXED, __HIP_MEMORY_SCOPE_AGENT); }
__device__ __forceinline__ unsigned xb_xcc_id() { return (unsigned)__builtin_amdgcn_s_getreg((3 << 11) | 20) & 0xFu; }
#define XB_SPIN(cond, bar) do { unsigned _sp = 0; while (cond) { __builtin_amdgcn_s_sleep(1); \
    if ((++_sp & 255u) == 0u) { if (xb_ld(&(bar)[XB_TMO])) break; if (_sp > XB_SPIN_CAP) { atomicAdd(&(bar)[XB_TMO], 1u); break; } } } } while (0)
struct XcdBarrier { unsigned* bar; unsigned x; volatile LAS unsigned* st; };
__device__ __forceinline__ XcdBarrier xcd_barrier_post(unsigned* bar, volatile LAS unsigned* st) {
    XcdBarrier b; b.bar = bar; b.x = xb_xcc_id(); b.st = st;
    if (my_tid() == 0) (void)xb_add(&bar[XB_XCNT(b.x)], 1u);
    return b;
}
__device__ __forceinline__ void xcd_barrier_complete(unsigned* bar, unsigned x, unsigned& nloc, unsigned& nx) {
    const unsigned G = gridDim.x * gridDim.y * gridDim.z;
    unsigned sum, cnt, mine, sp = 0u;
    for (;;) {
        sum = 0u; cnt = 0u; mine = 0u;
#pragma unroll
        for (unsigned j = 0; j < 16; ++j) { const unsigned c = xb_ld(&bar[XB_XCNT(j)]); sum += c; cnt += (c > 0u) ? 1u : 0u; mine = (j == x) ? c : mine; }
        if (sum == G) break;
        __builtin_amdgcn_s_sleep(1);
        if ((++sp & 255u) == 0u) { if (xb_ld(&bar[XB_TMO])) break; if (sp > XB_SPIN_CAP) { atomicAdd(&bar[XB_TMO], 1u); break; } }
    }
    nloc = mine > 0u ? mine : 1u; nx = cnt > 0u ? cnt : 1u;
}
__device__ __forceinline__ void xcd_barrier(const XcdBarrier& b) {
    asm volatile("s_waitcnt vmcnt(0)" ::: "memory");
    __syncthreads();
    if (my_tid() == 0) {
        unsigned* bar = b.bar;
        __builtin_amdgcn_s_waitcnt(0);
        unsigned nloc = b.st[0], nx = b.st[1];
        if (nloc == 0u) { xcd_barrier_complete(bar, b.x, nloc, nx); b.st[0] = nloc; b.st[1] = nx; }
        const unsigned old = xb_add(&bar[XB_XSUB(b.x)], 1u);
        const unsigned gen = old / nloc;
        if (old + 1u == (gen + 1u) * nloc) {
            __builtin_amdgcn_fence(__ATOMIC_RELEASE, "agent");
            asm volatile("s_waitcnt vmcnt(0)" ::: "memory");
            const unsigned og = xb_add(&bar[XB_TOP], 1u);
            const unsigned tg = og / nx;
            if (og + 1u == (tg + 1u) * nx) xb_add(&bar[XB_TOPGEN], 1u);
            else XB_SPIN(xb_ld(&bar[XB_TOPGEN]) == tg, bar);
            __builtin_amdgcn_fence(__ATOMIC_ACQUIRE, "agent");
            xb_add(&bar[XB_XGEN(b.x)], 1u);
            asm volatile("s_waitcnt vmcnt(0)" ::: "memory");
        } else {
            XB_SPIN(xb_ld(&bar[XB_XGEN(b.x)]) == gen, bar);
            __builtin_amdgcn_fence(__ATOMIC_ACQUIRE, "agent");
            asm volatile("s_waitcnt vmcnt(0)" ::: "memory");
        }
    }
    __syncthreads();
}

namespace pg8 {
struct EpiInProj {
  static constexpr bool PERM = true, AFTER_DRAIN = false;
  float* PA; bf16_t* PB; const u64_t* ssq;
  __device__ __forceinline__ void operator()(const f32x4 (&acc_)[2][2][4][2], const Unit& u, int wr, int wc, int fr, int fq) const {
    const int row0 = u.pm * BM + wr * 64 + fr;
    f32x4 acc[2][2][4][2];
#pragma unroll
    for (int ai = 0; ai < 2; ++ai)
#pragma unroll
      for (int m = 0; m < 4; ++m) { const float rs = row_rstd(ssq + row0 + ai * HALF + m * 16);
#pragma unroll
        for (int bj = 0; bj < 2; ++bj) { acc[ai][bj][m][0] = acc_[ai][bj][m][0] * rs; acc[ai][bj][m][1] = acc_[ai][bj][m][1] * rs; } }
    if (u.pn < 5) {
      const int col0 = u.pn * BM + wc * 32 + 8 * fq;
#pragma unroll
      for (int ai = 0; ai < 2; ++ai)
#pragma unroll
        for (int m = 0; m < 4; ++m) { float* rowp = PA + (size_t)(row0 + ai * HALF + m * 16) * PA_W + col0;
#pragma unroll
          for (int bj = 0; bj < 2; ++bj) { *(f32x4*)(rowp + bj * HALF) = acc[ai][bj][m][0]; *(f32x4*)(rowp + bj * HALF + 4) = acc[ai][bj][m][1]; } }
    } else {
      const int col0 = (u.pn - 5) * BM + wc * 32 + 8 * fq;
#pragma unroll
      for (int ai = 0; ai < 2; ++ai)
#pragma unroll
        for (int m = 0; m < 4; ++m) { bf16_t* rowp = PB + (size_t)(row0 + ai * HALF + m * 16) * PB_W + col0;
#pragma unroll
          for (int bj = 0; bj < 2; ++bj) { const f32x4 v0 = acc[ai][bj][m][0], v1 = acc[ai][bj][m][1]; u32x4 w;
            w.x = pk2(v0[0], v0[1]); w.y = pk2(v0[2], v0[3]); w.z = pk2(v1[0], v1[1]); w.w = pk2(v1[2], v1[3]); *(u32x4*)(rowp + bj * HALF) = w; } }
    }
  }
};
struct EpiRes {
  static constexpr bool PERM = true, AFTER_DRAIN = false;
  const float* res; float* out; bf16_t* xb; u64_t* ssq;
  __device__ __forceinline__ void operator()(const f32x4 (&acc)[2][2][4][2], const Unit& u, int wr, int wc, int fr, int fq) const {
    const int row0 = u.pm * BM + wr * 64 + fr, col0 = u.pn * BM + wc * 32 + 8 * fq;
#pragma unroll
    for (int ai = 0; ai < 2; ++ai)
#pragma unroll
      for (int m = 0; m < 4; ++m) { const size_t off = (size_t)(row0 + ai * HALF + m * 16) * DM + col0; float ss = 0.f;
#pragma unroll
        for (int bj = 0; bj < 2; ++bj) { const f32x4 r0 = *(const f32x4*)(res + off + bj * HALF), r1 = *(const f32x4*)(res + off + bj * HALF + 4);
          const f32x4 v0 = r0 + acc[ai][bj][m][0], v1 = r1 + acc[ai][bj][m][1];
          *(f32x4*)(out + off + bj * HALF) = v0; *(f32x4*)(out + off + bj * HALF + 4) = v1;
          if (xb) { u32x4 w; w.x = pk2(v0[0], v0[1]); w.y = pk2(v0[2], v0[3]); w.z = pk2(v1[0], v1[1]); w.w = pk2(v1[2], v1[3]); *(u32x4*)(xb + off + bj * HALF) = w;
            ss += (v0[0] * v0[0] + v0[1] * v0[1]) + (v0[2] * v0[2] + v0[3] * v0[3]) + (v1[0] * v1[0] + v1[1] * v1[1]) + (v1[2] * v1[2] + v1[3] * v1[3]); } }
        if (xb) { ss += __shfl_xor(ss, 16); ss += __shfl_xor(ss, 32); if (fq == 0) atomicAdd(ssq + row0 + ai * HALF + m * 16, ssq_fix(ss)); } }
  }
};
struct EpiRelu2 {
  static constexpr bool PERM = true, AFTER_DRAIN = false;
  bf16_t* H; const u64_t* ssq;
  __device__ __forceinline__ void operator()(const f32x4 (&acc)[2][2][4][2], const Unit& u, int wr, int wc, int fr, int fq) const {
    const int row0 = u.pm * BM + wr * 64 + fr, col0 = u.pn * BM + wc * 32 + 8 * fq;
#pragma unroll
    for (int ai = 0; ai < 2; ++ai)
#pragma unroll
      for (int m = 0; m < 4; ++m) { bf16_t* rowp = H + (size_t)(row0 + ai * HALF + m * 16) * DFF + col0; const float rs = row_rstd(ssq + row0 + ai * HALF + m * 16);
#pragma unroll
        for (int bj = 0; bj < 2; ++bj) { f32x4 v0 = acc[ai][bj][m][0], v1 = acc[ai][bj][m][1];
#pragma unroll
          for (int e = 0; e < 4; ++e) { const float a = fmaxf(v0[e], 0.f) * rs, b = fmaxf(v1[e], 0.f) * rs; v0[e] = a * a; v1[e] = b * b; }
          u32x4 w; w.x = pk2(v0[0], v0[1]); w.y = pk2(v0[2], v0[3]); w.z = pk2(v1[0], v1[1]); w.w = pk2(v1[2], v1[3]); *(u32x4*)(rowp + bj * HALF) = w; } }
  }
};
}
DI void transpose_item(const float* W, const float* gain, int K, int N, bf16_t* WT, LAS float* scr, int item, int lane) {
  const int nblk = N / 32, kb = item / nblk, nb = item % nblk, k0 = 64 * kb, n0 = 32 * nb;
#pragma unroll 8
  for (int i = 0; i < 32; ++i) { const int kk = 2 * i + (lane >> 5); const float gsc = gain ? gain[k0 + kk] : 1.f;
    scr[kk * 33 + (lane & 31)] = W[(size_t)(k0 + kk) * N + n0 + (lane & 31)] * gsc; }
  asm volatile("s_waitcnt lgkmcnt(0)" ::: "memory");
  const int c = lane & 7;
#pragma unroll
  for (int j = 0; j < 4; ++j) { const int n = (lane >> 3) + 8 * j; const LAS float* s = scr + (8 * c) * 33 + n;
    u32x4 o; o.x = pk2(s[0 * 33], s[1 * 33]); o.y = pk2(s[2 * 33], s[3 * 33]); o.z = pk2(s[4 * 33], s[5 * 33]); o.w = pk2(s[6 * 33], s[7 * 33]);
    *(u32x4*)(WT + (size_t)(n0 + n) * K + k0 + 8 * c) = o; }
  asm volatile("s_waitcnt lgkmcnt(0)" ::: "memory");
}
DI void prologue_weights(const Ctx& c, CArgsP a) {
  LAS float* scr = (LAS float*)(c.lds + c.wave * 16384);
  const int gw = c.bid * 8 + c.wave, NGW = c.G * 8;
  constexpr int I_IN = (DM / 64) * (NIN / 32), I_OUT = (DM / 64) * (DM / 32), I_UP = (DM / 64) * (DFF / 32), I_DN = (DFF / 64) * (DM / 32), I_GL = (256 / 64) * (256 / 32);
  constexpr int PER = I_IN + I_OUT + I_UP + I_DN + I_GL;
  for (int it = gw; it < DEPTH * PER; it += NGW) {
    const int l = it / PER; int r = it % PER;
    unsigned char* wb = a->ws + WS_W + (size_t)l * LAYER_W;
    if (r < I_IN) { transpose_item((const float*)a->in[4] + (size_t)l * DM * NIN, (const float*)a->in[3] + l * DM, DM, NIN, (bf16_t*)(wb + W_IN_OFF), scr, r, c.lane); continue; } r -= I_IN;
    if (r < I_OUT) { transpose_item((const float*)a->in[23] + (size_t)l * DM * DM, nullptr, DM, DM, (bf16_t*)(wb + W_OUT_OFF), scr, r, c.lane); continue; } r -= I_OUT;
    if (r < I_UP) { transpose_item((const float*)a->in[25] + (size_t)l * DM * DFF, (const float*)a->in[24] + l * DM, DM, DFF, (bf16_t*)(wb + W_UP_OFF), scr, r, c.lane); continue; } r -= I_UP;
    if (r < I_DN) { transpose_item((const float*)a->in[26] + (size_t)l * DFF * DM, nullptr, DFF, DM, (bf16_t*)(wb + W_DOWN_OFF), scr, r, c.lane); continue; } r -= I_DN;
    transpose_item((const float*)a->in[14] + (size_t)l * 256 * 256, nullptr, 256, 256, (bf16_t*)(wb + W_GLU_OFF), scr, r, c.lane);
  }
}
DI void convert_rows(const Ctx& c, const float* x, bf16_t* xn, u64_t* ssq) {
  const int gw = c.bid * 8 + c.wave, NGW = c.G * 8;
  for (int m = gw; m < M; m += NGW) {
    const f32x4* xr = (const f32x4*)(x + (size_t)m * DM) + c.lane;
    f32x4 v[4]; float s = 0.f;
#pragma unroll
    for (int j = 0; j < 4; ++j) { v[j] = xr[64 * j]; s += (v[j].x * v[j].x + v[j].y * v[j].y) + (v[j].z * v[j].z + v[j].w * v[j].w); }
    s = wave_sum(s);
    if (c.lane == 0) ssq[m] = ssq_fix(s);
    unsigned long long* o8 = (unsigned long long*)(xn + (size_t)m * DM) + c.lane;
#pragma unroll
    for (int j = 0; j < 4; ++j) o8[64 * j] = (unsigned long long)pk2(v[j].x, v[j].y) | ((unsigned long long)pk2(v[j].z, v[j].w) << 32);
  }
}

DI void rope_table(const Ctx& c, const int* pos, f32x2* tab) {
  for (int i = c.bid * 512 + c.tid; i < M * 32; i += c.G * 512) { const int t = i >> 5, j = i & 31;
    const float inv_freq = powf(10000.f, -(float)(2 * j) / 64.f); const float ang = (float)pos[t] * inv_freq; float sn, cs; sincosf(ang, &sn, &cs);
    tab[i] = (f32x2){cs, sn}; }
}
DI void prep_qk(const Ctx& c, bf16_t* PB, const f32x2* tab, const float* gq, const float* gk) {
  const int gw = c.bid * 8 + c.wave, NGW = c.G * 8;
  const int sgi = c.lane >> 2, c4 = c.lane & 3;
  const float* gain = (sgi >= 8) ? gk : gq; const float scale = (sgi >= 8) ? 1.f : 0.125f * LOG2E;
  float g1[8], g2[8];
#pragma unroll
  for (int e = 0; e < 8; ++e) { g1[e] = gain[8 * c4 + e] * scale; g2[e] = gain[8 * c4 + 32 + e] * scale; }
#pragma unroll 2
  for (int row = gw; row < M; row += NGW) {
    bf16_t* base = PB + (size_t)row * PB_W + sgi * 64 + 8 * c4;
    const u32x4 a = *(const u32x4*)base, b = *(const u32x4*)(base + 32);
    const f32x4* tp = (const f32x4*)(tab + (size_t)row * 32 + 8 * c4);
    const f32x4 r0 = tp[0], r1 = tp[1], r2 = tp[2], r3 = tp[3];
    const float cs[8] = {r0.x, r0.z, r1.x, r1.z, r2.x, r2.z, r3.x, r3.z}, sn[8] = {r0.y, r0.w, r1.y, r1.w, r2.y, r2.w, r3.y, r3.w};
    float t1[8], t2[8]; float ss = 0.f;
#pragma unroll
    for (int e = 0; e < 4; ++e) { t1[2 * e] = __uint_as_float(a[e] << 16); t1[2 * e + 1] = __uint_as_float(a[e] & 0xffff0000u); t2[2 * e] = __uint_as_float(b[e] << 16); t2[2 * e + 1] = __uint_as_float(b[e] & 0xffff0000u); }
#pragma unroll
    for (int e = 0; e < 8; ++e) ss += t1[e] * t1[e] + t2[e] * t2[e];
    ss += dpp_xor1(ss); ss += dpp_xor2(ss);
    const float r = 1.f / sqrtf(ss * (1.f / 64.f) + EPS);
    u32x4 oa, ob;
#pragma unroll
    for (int e = 0; e < 4; ++e) {
      const float x1a = t1[2 * e] * r * g1[2 * e], x2a = t2[2 * e] * r * g2[2 * e], x1b = t1[2 * e + 1] * r * g1[2 * e + 1], x2b = t2[2 * e + 1] * r * g2[2 * e + 1];
      oa[e] = pk2(x1a * cs[2 * e] - x2a * sn[2 * e], x1b * cs[2 * e + 1] - x2b * sn[2 * e + 1]);
      ob[e] = pk2(x2a * cs[2 * e] + x1a * sn[2 * e], x2b * cs[2 * e + 1] + x1b * sn[2 * e + 1]);
    }
    *(u32x4*)base = oa; *(u32x4*)(base + 32) = ob;
  }
}
DI int swap23(int p) { return (p & 3) | ((p & 4) << 1) | ((p & 8) >> 1); }
DI void prep_vt(const Ctx& c, const bf16_t* PB, bf16_t* Vt) {
  LAS unsigned char* T = c.lds;
  for (int u = c.bid; u < (M / 64) * 4; u += c.G) {
    const int tb = u >> 2, h = u & 3;
#pragma unroll
    for (int i = 0; i < 2; ++i) { const int idx = c.tid + 512 * i, r = idx >> 4, ch = idx & 15;
      const u32x4 v = *(const u32x4*)(PB + (size_t)(tb * 64 + r) * PB_W + 1024 + h * 128 + ch * 8);
      LAS unsigned* d = (LAS unsigned*)(T + r * 260 + ch * 16); d[0] = v.x; d[1] = v.y; d[2] = v.z; d[3] = v.w; }
    wg_sync();
#pragma unroll
    for (int i = 0; i < 2; ++i) { const int idx = c.tid + 512 * i, dv = idx >> 3, pc = idx & 7;
      unsigned w[4];
#pragma unroll
      for (int e = 0; e < 4; ++e) { const int p0 = 8 * pc + 2 * e, p1 = p0 + 1;
        const int k0 = (p0 & ~15) | swap23(p0 & 15), k1 = (p1 & ~15) | swap23(p1 & 15);
        const unsigned lo = *(const LAS unsigned short*)(T + k0 * 260 + dv * 2), hi = *(const LAS unsigned short*)(T + k1 * 260 + dv * 2);
        w[e] = lo | (hi << 16); }
      u32x4 o; o.x = w[0]; o.y = w[1]; o.z = w[2]; o.w = w[3];
      *(u32x4*)(Vt + ((size_t)(h * 128 + dv)) * M + tb * 64 + 8 * pc) = o; }
    wg_sync();
  }
}

DI float hgrn_lb(const float* lbw, int l, int j) {
  if (l == 0) return 0.f;
  const float a0 = lbw[j], a1 = lbw[256 + j]; const float mx = fmaxf(a0, a1), e0 = __expf(a0 - mx), e1 = __expf(a1 - mx);
  const float sm0 = e0 / (e0 + e1), sm1 = e1 / (e0 + e1); const float v = (sm0 + sm1) - sm0;
  return fminf(fmaxf(v, 0.f), 1.f);
}
template <bool PASSB>
DI void hgrn_pass(const Ctx& c, const float* PA, const float* lbw, int l, float* U, float* Dg, const float* Sin, const float* gng, bf16_t* MIX) {
  LAS float* F = (LAS float*)c.lds; LAS float* V = F + 8192; LAS float* Q = F + 16384;
  const int kseg = c.lane & 7, vv = c.lane >> 3, vcol = 8 * c.wave + vv;
  f32x4 rf[4], ri[4], rq[4]; float rS[8];
#define HG_LOAD_RAW(uu) do { const int ch_ = (uu) >> 2, h_ = (uu) & 3; \
    _Pragma("unroll") for (int i = 0; i < 4; ++i) { const int idx = c.tid + 512 * i, r = idx >> 4, c4 = idx & 15; const float* rowp = PA + (size_t)(ch_ * 128 + r) * PA_W + h_ * 64 + 4 * c4; \
      rf[i] = *(const f32x4*)(rowp + 256); ri[i] = *(const f32x4*)(rowp + 512); if (PASSB) rq[i] = *(const f32x4*)rowp; } \
    if (PASSB) { _Pragma("unroll") for (int j = 0; j < 8; ++j) rS[j] = Sin[(size_t)(uu) * 4096 + (8 * kseg + j) * 64 + vcol]; } } while (0)
  int u = c.bid;
  if (u < 512) HG_LOAD_RAW(u);
  while (u < 512) {
    const int ch = u >> 2, h = u & 3, t0 = ch * 128;
#pragma unroll
    for (int i = 0; i < 4; ++i) { const int idx = c.tid + 512 * i, r = idx >> 4, c4 = idx & 15; f32x4 f;
#pragma unroll
      for (int e = 0; e < 4; ++e) { const float lb = hgrn_lb(lbw, l, h * 64 + 4 * c4 + e); f[e] = lb + (1.f - lb) * sigmoidf_(rf[i][e]); }
      *(LAS f32x4*)(F + r * 64 + 4 * c4) = f; *(LAS f32x4*)(V + r * 64 + 4 * c4) = ri[i];
      if (PASSB) { f32x4 q;
#pragma unroll
        for (int e = 0; e < 4; ++e) q[e] = rq[i][e] * sigmoidf_(rq[i][e]);
        *(LAS f32x4*)(Q + r * 64 + 4 * c4) = q; } }
    float S[8];
#pragma unroll
    for (int j = 0; j < 8; ++j) S[j] = PASSB ? rS[j] : 0.f;
    wg_sync();
    const int un = u + c.G;
    if (un < 512) HG_LOAD_RAW(un);
    f32x4 fa_n = *(const LAS f32x4*)(F + 8 * kseg), fb_n = *(const LAS f32x4*)(F + 8 * kseg + 4); float v_n = V[vcol];
    f32x4 qa_n = {0.f, 0.f, 0.f, 0.f}, qb_n = qa_n;
    if (PASSB) { qa_n = *(const LAS f32x4*)(Q + 8 * kseg); qb_n = *(const LAS f32x4*)(Q + 8 * kseg + 4); }
#pragma unroll 4
    for (int t = 0; t < 128; ++t) {
      const f32x4 fa = fa_n, fb = fb_n, qa = qa_n, qb = qb_n; const float v1 = v_n;
      const int tn = (t + 1 < 128) ? t + 1 : 127;
      fa_n = *(const LAS f32x4*)(F + tn * 64 + 8 * kseg); fb_n = *(const LAS f32x4*)(F + tn * 64 + 8 * kseg + 4); v_n = V[tn * 64 + vcol];
      if (PASSB) { qa_n = *(const LAS f32x4*)(Q + tn * 64 + 8 * kseg); qb_n = *(const LAS f32x4*)(Q + tn * 64 + 8 * kseg + 4); }
#pragma unroll
      for (int j = 0; j < 4; ++j) { S[j] = fmaf(fa[j], S[j] - v1, v1); S[4 + j] = fmaf(fb[j], S[4 + j] - v1, v1); }
      if (PASSB) {
        float o = 0.f;
#pragma unroll
        for (int j = 0; j < 4; ++j) { o += qa[j] * S[j]; o += qb[j] * S[4 + j]; }
        o += dpp_xor1(o); o += dpp_xor2(o); o += dpp_hmirror(o);
        if (kseg == 0) V[t * 64 + vcol] = o;
      }
    }
    if (!PASSB) {
#pragma unroll
      for (int j = 0; j < 8; ++j) U[(size_t)u * 4096 + (8 * kseg + j) * 64 + vcol] = S[j];
      if (c.tid < 64) { float p = 1.f;
        for (int t = 0; t < 128; ++t) p *= F[t * 64 + c.tid];
        Dg[u * 64 + c.tid] = p; }
    } else {
      wg_sync();
      const int r = c.tid >> 2, sg = c.tid & 3;
      float o[16]; float ss = 0.f;
#pragma unroll
      for (int e = 0; e < 16; ++e) { o[e] = V[r * 64 + 16 * sg + e]; ss += o[e] * o[e]; }
      ss += dpp_xor1(ss); ss += dpp_xor2(ss);
      const float rstd = 1.f / sqrtf(ss * (1.f / 64.f) + EPS);
      const float* gp = PA + (size_t)(t0 + r) * PA_W + 768 + h * 64 + 16 * sg;
      unsigned w[8];
#pragma unroll
      for (int e = 0; e < 16; e += 2) { const float g0 = gp[e], g1 = gp[e + 1];
        const float a0 = o[e] * rstd * gng[16 * sg + e] * (g0 * sigmoidf_(g0)), a1 = o[e + 1] * rstd * gng[16 * sg + e + 1] * (g1 * sigmoidf_(g1));
        w[e >> 1] = pk2(a0, a1); }
      u32x4* op = (u32x4*)(MIX + (size_t)(t0 + r) * DM + h * 64 + 16 * sg);
      u32x4 w0, w1; w0.x = w[0]; w0.y = w[1]; w0.z = w[2]; w0.w = w[3]; w1.x = w[4]; w1.y = w[5]; w1.z = w[6]; w1.w = w[7];
      op[0] = w0; op[1] = w1;
    }
    wg_sync();
    u = un;
  }
#undef HG_LOAD_RAW
}
DI void hgrn_passA_mfma(const Ctx& c, const float* PA, const float* lbw, int l, float* U, float* Dg) {
  LAS float* F = (LAS float*)c.lds; LAS float* V = F + 8192;
  LAS unsigned char* KD = c.lds + 65536; LAS unsigned char* VT = c.lds + 65536 + 17408; LAS float* TS = (LAS float*)(c.lds + 65536 + 2 * 17408);
  const int kk = c.tid & 63, seg = c.tid >> 6;
  for (int u = c.bid; u < 512; u += c.G) {
    const int ch = u >> 2, h = u & 3, t0 = ch * 128;
#pragma unroll
    for (int i = 0; i < 4; ++i) { const int idx = c.tid + 512 * i, r = idx >> 4, c4 = idx & 15;
      const float* rowp = PA + (size_t)(t0 + r) * PA_W + h * 64 + 4 * c4;
      const f32x4 xf = *(const f32x4*)(rowp + 256), xi = *(const f32x4*)(rowp + 512); f32x4 f;
#pragma unroll
      for (int e = 0; e < 4; ++e) { const float lb = hgrn_lb(lbw, l, h * 64 + 4 * c4 + e); f[e] = lb + (1.f - lb) * sigmoidf_(xf[e]); }
      *(LAS f32x4*)(F + r * 64 + 4 * c4) = f; *(LAS f32x4*)(V + r * 64 + 4 * c4) = xi; }
    wg_sync();
    float fv[16], pl[16];
#pragma unroll
    for (int j = 0; j < 16; ++j) fv[j] = F[(seg * 16 + j) * 64 + kk];
    float p = 1.f;
#pragma unroll
    for (int j = 15; j >= 0; --j) { pl[j] = p; p *= fv[j]; }
    TS[seg * 64 + kk] = p;
    { unsigned w[8];
#pragma unroll
      for (int j = 0; j < 16; j += 2) w[j >> 1] = pk2(V[(seg * 16 + j) * 64 + kk], V[(seg * 16 + j + 1) * 64 + kk]);
      u32x4 w0, w1; w0.x = w[0]; w0.y = w[1]; w0.z = w[2]; w0.w = w[3]; w1.x = w[4]; w1.y = w[5]; w1.z = w[6]; w1.w = w[7];
      LAS u32x4* d = (LAS u32x4*)(VT + kk * 272 + seg * 32); d[0] = w0; d[1] = w1; }
    wg_sync();
    float suf = 1.f;
#pragma unroll
    for (int sg = 1; sg < 8; ++sg) { const float tsv = TS[sg * 64 + kk]; if (sg > seg) suf *= tsv; }
    if (seg == 0) Dg[u * 64 + kk] = p * suf;
    { unsigned w[8];
#pragma unroll
      for (int j = 0; j < 16; j += 2) w[j >> 1] = pk2((1.f - fv[j]) * pl[j] * suf, (1.f - fv[j + 1]) * pl[j + 1] * suf);
      u32x4 w0, w1; w0.x = w[0]; w0.y = w[1]; w0.z = w[2]; w0.w = w[3]; w1.x = w[4]; w1.y = w[5]; w1.z = w[6]; w1.w = w[7];
      LAS u32x4* d = (LAS u32x4*)(KD + kk * 272 + seg * 32); d[0] = w0; d[1] = w1; }
    wg_sync();
    { const int r16 = c.lane & 15, q4 = c.lane >> 4, mb = c.wave >> 1, nbp = c.wave & 1;
      f32x4 acc[2]; acc[0] = (f32x4){0.f, 0.f, 0.f, 0.f}; acc[1] = acc[0];
#pragma unroll
      for (int ks = 0; ks < 4; ++ks) { const bf16x8 af = *(const LAS bf16x8*)(KD + (16 * mb + r16) * 272 + (32 * ks + 8 * q4) * 2);
#pragma unroll
        for (int n2 = 0; n2 < 2; ++n2) { const bf16x8 bfv = *(const LAS bf16x8*)(VT + (16 * (2 * nbp + n2) + r16) * 272 + (32 * ks + 8 * q4) * 2);
          acc[n2] = __builtin_amdgcn_mfma_f32_16x16x32_bf16(af, bfv, acc[n2], 0, 0, 0); } }
      asm volatile("s_nop 7\n\ts_nop 7\n\ts_nop 7" :: "v"(acc[0]), "v"(acc[1]));
#pragma unroll
      for (int n2 = 0; n2 < 2; ++n2)
#pragma unroll
        for (int i = 0; i < 4; ++i) U[(size_t)u * 4096 + (16 * mb + 4 * q4 + i) * 64 + 16 * (2 * nbp + n2) + r16] = acc[n2][i]; }
    wg_sync();
  }
}
DI void hgrn_scan(const Ctx& c, const float* U, const float* Dg, float* Sin) {
  const int e = c.bid * 512 + c.tid, h = e >> 12, k = (e >> 6) & 63;
  float S = 0.f;
  for (int c0 = 0; c0 < 128; c0 += 32) {
    float uu[32], dd[32];
#pragma unroll
    for (int i = 0; i < 32; ++i) { uu[i] = U[(size_t)(c0 + i) * 16384 + e]; dd[i] = Dg[((c0 + i) * 4 + h) * 64 + k]; }
#pragma unroll
    for (int i = 0; i < 32; ++i) { Sin[(size_t)(c0 + i) * 16384 + e] = S; S = dd[i] * S + uu[i]; }
  }
}

struct S5Coef { float ar, ai; float Bre[16], Bim[16]; };
DI void s5_coef(CArgsP a, int l, int g, int p, S5Coef& k) {
  const int gp = (l * 16 + g) * 64 + p;
  const float lr = fminf(((const float*)a->in[6])[gp], -1e-4f), li = ((const float*)a->in[7])[gp], dt = __expf(((const float*)a->in[8])[gp]);
  const float er = __expf(lr * dt); float sn, cs; sincosf(li * dt, &sn, &cs);
  k.ar = er * cs; k.ai = er * sn;
  const float den = 1.f / (lr * lr + li * li), nr = k.ar - 1.f, ni = k.ai;
  const float sr = (nr * lr + ni * li) * den, si = (ni * lr - nr * li) * den;
  const float* bre = (const float*)a->in[9] + (size_t)gp * 16; const float* bim = (const float*)a->in[10] + (size_t)gp * 16;
#pragma unroll
  for (int h = 0; h < 16; ++h) { const float br = bre[h], bi = bim[h]; k.Bre[h] = br * sr - bi * si; k.Bim[h] = br * si + bi * sr; }
}
DI void s5_bu_tile(const LAS float* Ut, int sub, int g, const bf16x8 (&bfr)[8], LAS unsigned char* BUs, int lane) {
  const int r16 = lane & 15, q4 = lane >> 4;
  u32x4 aw = {0u, 0u, 0u, 0u};
  if (q4 < 2) { const LAS float* up = Ut + (16 * sub + r16) * 256 + 16 * g + 8 * q4; const f32x4 u0 = *(const LAS f32x4*)up, u1 = *(const LAS f32x4*)(up + 4);
    aw.x = pk2(u0.x, u0.y); aw.y = pk2(u0.z, u0.w); aw.z = pk2(u1.x, u1.y); aw.w = pk2(u1.z, u1.w); }
  const bf16x8 af = __builtin_bit_cast(bf16x8, aw);
  f32x4 acc[8];
#pragma unroll
  for (int nb = 0; nb < 8; ++nb) { const f32x4 z = {0.f, 0.f, 0.f, 0.f}; acc[nb] = __builtin_amdgcn_mfma_f32_16x16x32_bf16(af, bfr[nb], z, 0, 0, 0); }
  asm volatile("s_nop 7\n\ts_nop 7\n\ts_nop 7" :: "v"(aw.x), "v"(aw.y), "v"(aw.z), "v"(aw.w), "v"(acc[0]), "v"(acc[1]), "v"(acc[2]), "v"(acc[3]), "v"(acc[4]), "v"(acc[5]), "v"(acc[6]), "v"(acc[7]));
#pragma unroll
  for (int nb = 0; nb < 8; ++nb)
#pragma unroll
    for (int i = 0; i < 4; ++i) *(LAS float*)(BUs + (4 * q4 + i) * 528 + (16 * nb + r16) * 4) = acc[nb][i];
}
DI void s5_setup(CArgsP a, int l, int g, int lane, LAS unsigned char* tile, f32x2& ab, bf16x8 (&bfr)[8]) {
  S5Coef kc; s5_coef(a, l, g, lane, kc); ab.x = kc.ar; ab.y = kc.ai;
  u32x4 r0, r1, i0, i1;
  r0.x = pk2(kc.Bre[0], kc.Bre[1]); r0.y = pk2(kc.Bre[2], kc.Bre[3]); r0.z = pk2(kc.Bre[4], kc.Bre[5]); r0.w = pk2(kc.Bre[6], kc.Bre[7]);
  r1.x = pk2(kc.Bre[8], kc.Bre[9]); r1.y = pk2(kc.Bre[10], kc.Bre[11]); r1.z = pk2(kc.Bre[12], kc.Bre[13]); r1.w = pk2(kc.Bre[14], kc.Bre[15]);
  i0.x = pk2(kc.Bim[0], kc.Bim[1]); i0.y = pk2(kc.Bim[2], kc.Bim[3]); i0.z = pk2(kc.Bim[4], kc.Bim[5]); i0.w = pk2(kc.Bim[6], kc.Bim[7]);
  i1.x = pk2(kc.Bim[8], kc.Bim[9]); i1.y = pk2(kc.Bim[10], kc.Bim[11]); i1.z = pk2(kc.Bim[12], kc.Bim[13]); i1.w = pk2(kc.Bim[14], kc.Bim[15]);
  asm volatile("s_waitcnt lgkmcnt(0)" ::: "memory");
  LAS u32x4* st = (LAS u32x4*)(tile + lane * 64); st[0] = r0; st[1] = r1; st[2] = i0; st[3] = i1;
  asm volatile("s_waitcnt lgkmcnt(0)" ::: "memory");
  const int r16 = lane & 15, q4 = lane >> 4;
#pragma unroll
  for (int nb = 0; nb < 8; ++nb) { u32x4 w = {0u, 0u, 0u, 0u}; if (q4 < 2) w = *(const LAS u32x4*)(tile + (16 * nb + r16) * 32 + q4 * 16); bfr[nb] = __builtin_bit_cast(bf16x8, w); }
  asm volatile("s_waitcnt lgkmcnt(0)" ::: "memory");
}
DI void s5_load_u(const Ctx& c, const float* PA, int t0, LAS float* Ut) {
#pragma unroll
  for (int i = 0; i < 8; ++i) { const int idx = c.tid + 512 * i, r = idx >> 6, c4 = idx & 63;
    *(LAS f32x4*)(Ut + r * 256 + 4 * c4) = *(const f32x4*)(PA + (size_t)(t0 + r) * PA_W + 1024 + 4 * c4); }
}
DI void s5_step(const S5Coef& k, const LAS float* urow, float& xr, float& xi) {
  const f32x4 u0 = *(const LAS f32x4*)urow, u1 = *(const LAS f32x4*)(urow + 4), u2 = *(const LAS f32x4*)(urow + 8), u3 = *(const LAS f32x4*)(urow + 12);
  float br = 0.f, bi = 0.f;
#pragma unroll
  for (int e = 0; e < 4; ++e) { br += k.Bre[e] * u0[e]; bi += k.Bim[e] * u0[e]; br += k.Bre[4 + e] * u1[e]; bi += k.Bim[4 + e] * u1[e];
    br += k.Bre[8 + e] * u2[e]; bi += k.Bim[8 + e] * u2[e]; br += k.Bre[12 + e] * u3[e]; bi += k.Bim[12 + e] * u3[e]; }
  const float nr = k.ar * xr - k.ai * xi + br, ni = k.ar * xi + k.ai * xr + bi; xr = nr; xi = ni;
}
DI void s5_passA(const Ctx& c, CArgsP a, int l, const float* PA, f32x2* Xe) {
  LAS float* Ut = (LAS float*)c.lds; LAS unsigned char* BUs = c.lds + 65536 + c.wave * 8448;
  for (int u = c.bid; u < 256; u += c.G) {
    s5_load_u(c, PA, u * 64, Ut);
    wg_sync();
    for (int gi = 0; gi < 2; ++gi) { const int g = c.wave + 8 * gi;
      f32x2 ab; bf16x8 bfr[8]; s5_setup(a, l, g, c.lane, BUs, ab, bfr);
      float xr = 0.f, xi = 0.f;
      for (int sub = 0; sub < 4; ++sub) {
        asm volatile("" ::: "memory"); s5_bu_tile(Ut, sub, g, bfr, BUs, c.lane); asm volatile("" ::: "memory");
#pragma unroll 4
        for (int tt = 0; tt < 16; ++tt) { const LAS float* bp = (const LAS float*)(BUs + tt * 528 + 8 * c.lane); const float bur = bp[0], bui = bp[1];
          const float nr = ab.x * xr - ab.y * xi + bur, ni = ab.x * xi + ab.y * xr + bui; xr = nr; xi = ni; }
      }
      Xe[(size_t)(u * 16 + g) * 64 + c.lane] = (f32x2){xr, xi}; }
    wg_sync();
  }
}
DI void s5_scan(const Ctx& c, CArgsP a, int l, const f32x2* Xe, f32x2* Xin) {
  const int idx = (c.bid - 32) * 512 + c.tid;
  S5Coef k; s5_coef(a, l, idx >> 6, idx & 63, k);
  float pr = k.ar, pi = k.ai;
#pragma unroll
  for (int i = 0; i < 6; ++i) { const float nr = pr * pr - pi * pi, ni = 2.f * pr * pi; pr = nr; pi = ni; }
  float xr = 0.f, xi = 0.f;
  for (int c0 = 0; c0 < 256; c0 += 32) {
    f32x2 e[32];
#pragma unroll
    for (int i = 0; i < 32; ++i) e[i] = Xe[(size_t)(c0 + i) * 1024 + idx];
#pragma unroll
    for (int i = 0; i < 32; ++i) { Xin[(size_t)(c0 + i) * 1024 + idx] = (f32x2){xr, xi};
      const float nr = pr * xr - pi * xi + e[i].x, ni = pr * xi + pi * xr + e[i].y; xr = nr; xi = ni; }
  }
}
DI float gelu_tanh(float x) { const float u = 0.7978845608028654f * (x + 0.044715f * x * x * x); const float t = 1.f - 2.f / (1.f + __expf(2.f * u)); return 0.5f * x * (1.f + t); }
DI void s5_passB(const Ctx& c, CArgsP a, int l, const float* PA, const f32x2* Xin, const bf16_t* WgT, bf16_t* MIX) {
  LAS float* Ut = (LAS float*)c.lds;
  LAS unsigned char* XsB = c.lds + 65536 + c.wave * 8448;
  LAS unsigned char* Yb = c.lds + 65536;
  const float* cre = (const float*)a->in[11]; const float* cim = (const float*)a->in[12]; const float* dsk = (const float*)a->in[13];
  const float* ng = (const float*)a->in[15] + l * 256;
  for (int u = c.bid; u < 256; u += c.G) {
    const int t0 = u * 64;
    s5_load_u(c, PA, t0, Ut);
    wg_sync();
    for (int gi = 0; gi < 2; ++gi) { const int g = c.wave + 8 * gi;
      f32x2 ab; bf16x8 bfr[8]; s5_setup(a, l, g, c.lane, XsB, ab, bfr);
      const int hh = c.lane & 15, q4 = c.lane >> 4;
      bf16x8 cf[4];
#pragma unroll
      for (int ks = 0; ks < 4; ++ks) { const size_t ci = ((size_t)(l * 16 + g) * 16 + hh) * 64 + 16 * ks + 4 * q4;
        const f32x4 cr = *(const f32x4*)(cre + ci), cm = *(const f32x4*)(cim + ci); u32x4 w;
        w.x = pk2(cr.x, -cm.x); w.y = pk2(cr.y, -cm.y); w.z = pk2(cr.z, -cm.z); w.w = pk2(cr.w, -cm.w); cf[ks] = __builtin_bit_cast(bf16x8, w); }
      const float dh = dsk[(l * 16 + g) * 16 + hh];
      const f32x2 x0 = Xin[(size_t)(u * 16 + g) * 64 + c.lane]; float xr = x0.x, xi = x0.y;
      for (int sub = 0; sub < 4; ++sub) {
        asm volatile("" ::: "memory"); s5_bu_tile(Ut, sub, g, bfr, XsB, c.lane); asm volatile("" ::: "memory");
#pragma unroll 4
        for (int tt = 0; tt < 16; ++tt) { const LAS float* bp = (const LAS float*)(XsB + tt * 528 + 8 * c.lane); const float bur = bp[0], bui = bp[1];
          const float nr = ab.x * xr - ab.y * xi + bur, ni = ab.x * xi + ab.y * xr + bui; xr = nr; xi = ni;
          *(LAS float*)(XsB + tt * 528 + 4 * c.lane) = __uint_as_float(pk2(xr, xi)); }
        asm volatile("" ::: "memory");
        f32x4 acc = {0.f, 0.f, 0.f, 0.f};
#pragma unroll
        for (int ks = 0; ks < 4; ++ks) { const LAS float* ap = (const LAS float*)(XsB + hh * 528 + (32 * ks + 8 * q4) * 2); const f32x4 afv = {ap[0], ap[1], ap[2], ap[3]}; const bf16x8 af = __builtin_bit_cast(bf16x8, afv); acc = __builtin_amdgcn_mfma_f32_16x16x32_bf16(af, cf[ks], acc, 0, 0, 0); }
#pragma unroll
        for (int i = 0; i < 4; ++i) { LAS float* yp = Ut + (16 * sub + 4 * q4 + i) * 256 + 16 * g + hh; *yp = gelu_tanh(acc[i] + dh * (*yp)); }
      }
    }
    wg_sync();
#pragma unroll
    for (int i = 0; i < 8; ++i) { const int idx = c.tid + 512 * i, r = idx >> 6, c4 = idx & 63;
      const f32x4 v = *(const LAS f32x4*)(Ut + r * 256 + 4 * c4); u32x2 w; w.x = pk2(v.x, v.y); w.y = pk2(v.z, v.w);
      *(LAS u32x2*)(Yb + r * 528 + c4 * 8) = w; }
    wg_sync();
    {
      const int r16 = c.lane & 15, q4 = c.lane >> 4;
      f32x4 z[4][2];
#pragma unroll
      for (int m = 0; m < 4; ++m) { z[m][0] = (f32x4){0.f, 0.f, 0.f, 0.f}; z[m][1] = z[m][0]; }
#pragma unroll
      for (int ks = 0; ks < 8; ++ks) {
        bf16x8 bfr[2], afr[4];
#pragma unroll
        for (int n = 0; n < 2; ++n) bfr[n] = *(const bf16x8*)(WgT + (size_t)(32 * c.wave + 16 * n + r16) * 256 + 32 * ks + 8 * q4);
#pragma unroll
        for (int m = 0; m < 4; ++m) afr[m] = *(const LAS bf16x8*)(Yb + (16 * m + r16) * 528 + (32 * ks + 8 * q4) * 2);
#pragma unroll
        for (int m = 0; m < 4; ++m)
#pragma unroll
          for (int n = 0; n < 2; ++n) z[m][n] = __builtin_amdgcn_mfma_f32_16x16x32_bf16(afr[m], bfr[n], z[m][n], 0, 0, 0);
      }
#pragma unroll
      for (int m = 0; m < 4; ++m)
#pragma unroll
        for (int n = 0; n < 2; ++n)
#pragma unroll
          for (int e = 0; e < 4; ++e) { LAS float* yp = Ut + (16 * m + 4 * q4 + e) * 256 + 32 * c.wave + 16 * n + r16; const float y = *yp; *yp = y * sigmoidf_(z[m][n][e]); }
    }
    wg_sync();
    {
      const int r = c.tid >> 3, sg = c.tid & 7; float o[32]; float ss = 0.f;
#pragma unroll
      for (int e = 0; e < 32; e += 4) { const f32x4 v = *(const LAS f32x4*)(Ut + r * 256 + 32 * sg + e); o[e] = v.x; o[e + 1] = v.y; o[e + 2] = v.z; o[e + 3] = v.w;
        ss += (v.x * v.x + v.y * v.y) + (v.z * v.z + v.w * v.w); }
      ss += dpp_xor1(ss); ss += dpp_xor2(ss); ss += dpp_hmirror(ss);
      const float rstd = 1.f / sqrtf(ss * (1.f / 256.f) + EPS);
      u32x4* op = (u32x4*)(MIX + (size_t)(t0 + r) * DM + 256 + 32 * sg);
#pragma unroll
      for (int e = 0; e < 32; e += 8) { u32x4 w;
        w.x = pk2(o[e] * rstd * ng[32 * sg + e], o[e + 1] * rstd * ng[32 * sg + e + 1]); w.y = pk2(o[e + 2] * rstd * ng[32 * sg + e + 2], o[e + 3] * rstd * ng[32 * sg + e + 3]);
        w.z = pk2(o[e + 4] * rstd * ng[32 * sg + e + 4], o[e + 5] * rstd * ng[32 * sg + e + 5]); w.w = pk2(o[e + 6] * rstd * ng[32 * sg + e + 6], o[e + 7] * rstd * ng[32 * sg + e + 7]);
        op[e >> 3] = w; }
    }
    wg_sync();
  }
}
#define MFMA32(a, b, c) __builtin_amdgcn_mfma_f32_32x32x16_bf16((a), (b), (c), 0, 0, 0)
DI void attn_phase(const Ctx& c, CArgsP a, int l, const bf16_t* PB, const bf16_t* Vt, bf16_t* MIX) {
  const float* gq = (const float*)a->in[16] + l * 64; const float* gk = (const float*)a->in[17] + l * 64;
  const float s1 = wave_sum(((const float*)a->in[18])[l * 64 + c.lane] * ((const float*)a->in[19])[l * 64 + c.lane]);
  const float s2 = wave_sum(((const float*)a->in[20])[l * 64 + c.lane] * ((const float*)a->in[21])[l * 64 + c.lane]);
  const float lam_init = 0.8f - 0.6f * expf(-0.3f * (float)l), lam = expf(s1) - expf(s2) + lam_init;
  const float* sg = (const float*)a->in[22] + l * 128;
  const int comp = c.wave >> 2, wq = c.wave & 3, n = c.lane & 31, g = c.lane >> 5, sbit = my_stagger();
  const int rK = c.tid >> 3, cK = c.tid & 7;
  for (int u = c.bid; u < 512; u += c.G) {
    const int h = u & 3, jj = (u & 255) >> 2, qb = (u < 256) ? jj : 127 - jj;
    const int q0 = qb * 128 + wq * 32, nt = 2 * (qb + 1);
    bf16x8 qf[4];
#pragma unroll
    for (int ks = 0; ks < 4; ++ks) qf[ks] = *(const bf16x8*)(PB + (size_t)(q0 + n) * PB_W + (h * 2 + comp) * 64 + 16 * ks + 8 * g);
    f32x16 o[4];
#pragma unroll
    for (int mt = 0; mt < 4; ++mt)
#pragma unroll
      for (int i = 0; i < 16; ++i) o[mt][i] = 0.f;
    float lsum = 0.f;
    const int drow = 8 * c.wave + (c.lane >> 3), dch = (c.lane & 7) ^ ((drow >> 1) & 7);
    const unsigned voffK = (unsigned)(drow * PB_W + dch * 8) * 2u, voffV = (unsigned)(drow * M + dch * 8) * 2u;
    const char* gK = (const char*)(PB + 512 + (h * 2) * 64);
    const char* gV = (const char*)(Vt + (size_t)(h * 128) * M);
#define ATT_LOAD(kt) do { LAS unsigned char* b_ = c.lds + ((kt) & 3) * 32768 + c.wave * 1024; const char* kp_ = gK + (size_t)(kt) * (64 * PB_W * 2); const char* vp_ = gV + (size_t)(kt) * 128; \
      __builtin_amdgcn_global_load_lds((const unsigned*)(kp_ + voffK), (LAS unsigned*)b_, 16, 0, 0); __builtin_amdgcn_global_load_lds((const unsigned*)(kp_ + 128 + voffK), (LAS unsigned*)(b_ + 8192), 16, 0, 0); \
      __builtin_amdgcn_global_load_lds((const unsigned*)(vp_ + voffV), (LAS unsigned*)(b_ + 16384), 16, 0, 0); __builtin_amdgcn_global_load_lds((const unsigned*)(vp_ + (size_t)64 * M * 2 + voffV), (LAS unsigned*)(b_ + 24576), 16, 0, 0); } while (0)
#define ATT_STORE(sb) do { } while (0)
    f32x16 s[2]; bf16x8 pf[4];
    const f32x16 zero16 = {0.f, 0.f, 0.f, 0.f, 0.f, 0.f, 0.f, 0.f, 0.f, 0.f, 0.f, 0.f, 0.f, 0.f, 0.f, 0.f};
#define ATT_ACTIVE(j) (64 * (j) <= q0 + 31)
#define ATT_S(j, s) do { const LAS unsigned char* Kc = c.lds + ((j) & 3) * 32768 + comp * 8192; \
      _Pragma("unroll") for (int ks = 0; ks < 4; ++ks) { bf16x8 kf[2]; _Pragma("unroll") for (int m = 0; m < 2; ++m) kf[m] = *(const LAS bf16x8*)(Kc + (32 * m + n) * 128 + (((2 * ks + g) ^ ((n >> 1) & 7)) * 16)); \
        _Pragma("unroll") for (int m = 0; m < 2; ++m) s[m] = (ks == 0) ? MFMA32(kf[m], qf[0], zero16) : MFMA32(kf[m], qf[ks], s[m]); } } while (0)
#define ATT_MASK(j, s) do { if (64 * (j) + 63 > q0) { const int qrow = q0 + n; \
        _Pragma("unroll") for (int m = 0; m < 2; ++m) _Pragma("unroll") for (int i = 0; i < 16; ++i) { const int key = 64 * (j) + 32 * m + (i & 3) + 8 * (i >> 2) + 4 * g; if (key > qrow) s[m][i] = -INFINITY; } } } while (0)
#define ATT_P(s) do { \
      _Pragma("unroll") for (int m = 0; m < 2; ++m) _Pragma("unroll") for (int i = 0; i < 16; ++i) { const float p = __builtin_amdgcn_exp2f(s[m][i]); s[m][i] = p; lsum += p; } \
      _Pragma("unroll") for (int kk = 0; kk < 4; ++kk) { const int m = kk >> 1, b = 8 * (kk & 1); u32x4 w; \
        w.x = pk2(s[m][b], s[m][b + 1]); w.y = pk2(s[m][b + 2], s[m][b + 3]); w.z = pk2(s[m][b + 4], s[m][b + 5]); w.w = pk2(s[m][b + 6], s[m][b + 7]); pf[kk] = __builtin_bit_cast(bf16x8, w); } } while (0)
#define ATT_V(j) do { const LAS unsigned char* Vs = c.lds + ((j) & 3) * 32768 + 16384; \
      _Pragma("unroll") for (int kk = 0; kk < 4; ++kk) { bf16x8 vf[4]; _Pragma("unroll") for (int mt = 0; mt < 4; ++mt) vf[mt] = *(const LAS bf16x8*)(Vs + (32 * mt + n) * 128 + (((2 * kk + g) ^ ((n >> 1) & 7)) * 16)); \
        _Pragma("unroll") for (int mt = 0; mt < 4; ++mt) o[mt] = MFMA32(vf[mt], pf[kk], o[mt]); } } while (0)
    const __amdgpu_buffer_rsrc_t rsK = __builtin_amdgcn_make_buffer_rsrc((void*)gK, 0, 0x7fffffff, 0x00020000);
    const __amdgpu_buffer_rsrc_t rsV = __builtin_amdgcn_make_buffer_rsrc((void*)gV, 0, 0x7fffffff, 0x00020000);
#define ATT_LOADC(j) do { const int jc_ = (j) < nt ? (j) : nt - 1; LAS unsigned char* b_ = c.lds + ((j) & 3) * 32768 + c.wave * 1024; const unsigned sk_ = (unsigned)jc_ * (unsigned)(64 * PB_W * 2), sv_ = (unsigned)jc_ * 128u; \
      __builtin_amdgcn_raw_ptr_buffer_load_lds(rsK, (LAS unsigned*)b_, 16, voffK, sk_, 0, 0); __builtin_amdgcn_raw_ptr_buffer_load_lds(rsK, (LAS unsigned*)(b_ + 8192), 16, voffK, sk_ + 128u, 0, 0); \
      __builtin_amdgcn_raw_ptr_buffer_load_lds(rsV, (LAS unsigned*)(b_ + 16384), 16, voffV, sv_, 0, 0); __builtin_amdgcn_raw_ptr_buffer_load_lds(rsV, (LAS unsigned*)(b_ + 24576), 16, voffV, sv_ + (unsigned)(64 * M * 2), 0, 0); } while (0)
    ATT_LOADC(0); ATT_LOADC(1); ATT_LOADC(2);
    asm volatile("s_waitcnt vmcnt(4)\n\ts_barrier" ::: "memory");
    f32x16 s2[2];
    ATT_S(0, s);
    int kt = 0;
    for (; kt < nt - 2; kt += 2) {
      ATT_S(kt + 1, s2); ATT_P(s); ATT_LOADC(kt + 3); ATT_V(kt);
      asm volatile("s_waitcnt vmcnt(4) lgkmcnt(0)\n\ts_barrier" ::: "memory");
      ATT_S(kt + 2, s); ATT_P(s2); ATT_LOADC(kt + 4); ATT_V(kt + 1);
      asm volatile("s_waitcnt vmcnt(4) lgkmcnt(0)\n\ts_barrier" ::: "memory");
    }
    ATT_MASK(kt, s);
    if (ATT_ACTIVE(kt + 1)) { ATT_S(kt + 1, s2); ATT_MASK(kt + 1, s2); }
    ATT_P(s); ATT_V(kt);
    asm volatile("s_waitcnt vmcnt(0) lgkmcnt(0)\n\ts_barrier" ::: "memory");
    if (ATT_ACTIVE(kt + 1)) { ATT_P(s2); ATT_V(kt + 1); }
    asm volatile("s_waitcnt vmcnt(0) lgkmcnt(0)\n\ts_barrier" ::: "memory");
#undef ATT_MASK
#undef ATT_LOADC
#undef ATT_ACTIVE
#undef ATT_S
#undef ATT_P
#undef ATT_V
#undef ATT_LOAD
#undef ATT_STORE
    lsum += __shfl_xor(lsum, 32);
    const float inv = 1.f / lsum;
    LAS float* X = (LAS float*)c.lds; const int row = wq * 32 + n;
    if (comp == 1) {
#pragma unroll
      for (int mt = 0; mt < 4; ++mt)
#pragma unroll
        for (int i4 = 0; i4 < 4; ++i4) { f32x4 v = {o[mt][4 * i4] * inv, o[mt][4 * i4 + 1] * inv, o[mt][4 * i4 + 2] * inv, o[mt][4 * i4 + 3] * inv};
          *(LAS f32x4*)(X + row * 132 + 32 * mt + 8 * i4 + 4 * g) = v; }
    }
    wg_sync();
    if (comp == 0) {
      float ssq = 0.f;
#pragma unroll
      for (int mt = 0; mt < 4; ++mt)
#pragma unroll
        for (int i4 = 0; i4 < 4; ++i4) { const f32x4 x1 = *(const LAS f32x4*)(X + row * 132 + 32 * mt + 8 * i4 + 4 * g);
#pragma unroll
          for (int e = 0; e < 4; ++e) { const float d = o[mt][4 * i4 + e] * inv - lam * x1[e]; o[mt][4 * i4 + e] = d; ssq += d * d; } }
      ssq += __shfl_xor(ssq, 32);
      const float rstd = (1.f - lam_init) / sqrtf(ssq * (1.f / 128.f) + EPS);
      const float* sgp = sg; asm volatile("" : "+s"(sgp));
#pragma unroll
      for (int mt = 0; mt < 4; ++mt)
#pragma unroll
        for (int i4 = 0; i4 < 4; ++i4) { const int dv = 32 * mt + 8 * i4 + 4 * g; const f32x4 gg = *(const f32x4*)(sgp + dv);
          f32x4 v = {o[mt][4 * i4] * rstd * gg.x, o[mt][4 * i4 + 1] * rstd * gg.y, o[mt][4 * i4 + 2] * rstd * gg.z, o[mt][4 * i4 + 3] * rstd * gg.w};
          *(LAS f32x4*)(X + row * 132 + dv) = v; }
    }
    wg_sync();
    {
      const int r = c.tid >> 2, sgm = c.tid & 3;
      u32x4* op = (u32x4*)(MIX + (size_t)(qb * 128 + r) * DM + 512 + h * 128 + 32 * sgm);
#pragma unroll
      for (int e = 0; e < 4; ++e) { const f32x4 v0 = *(const LAS f32x4*)(X + r * 132 + 32 * sgm + 8 * e), v1 = *(const LAS f32x4*)(X + r * 132 + 32 * sgm + 8 * e + 4);
        u32x4 w; w.x = pk2(v0.x, v0.y); w.y = pk2(v0.z, v0.w); w.z = pk2(v1.x, v1.y); w.w = pk2(v1.z, v1.w); op[e] = w; }
    }
    wg_sync();
  }
}

__global__ void __launch_bounds__(512, 2) hymba_fwd(Args a_unused) {
  extern __shared__ __attribute__((aligned(16))) unsigned char lds_raw[];
  LAS unsigned char* lds = (LAS unsigned char*)lds_raw;
  __shared__ uint4 xb_words;
  if (threadIdx.x == 0) xb_words = make_uint4(0u, 0u, 0u, 0u);
  if (threadIdx.x < 4) g_simdcnt[threadIdx.x] = 0u;
  __syncthreads();
  if ((threadIdx.x & 63) == 0) { const unsigned r = atomicAdd(&g_simdcnt[(hw_slot() >> 4) & 3u], 1u); g_wtab[hw_slot()] = (threadIdx.x >> 6) | ((r & 1u) << 8); }
  __syncthreads();
  { CArgsP a = get_args(); if (blockIdx.x == 0) { unsigned* bw = (unsigned*)(a->ws + WS_BAR); for (int i = threadIdx.x; i < XCD_BAR_WORDS; i += 512) bw[i] = 0u; } }
#define WSP(T, off) ((T*)(a->ws + (off)))
  if (PH & 1) { CArgsP a = get_args(); Ctx c = mk_ctx(lds); prologue_weights(c, a); convert_rows(c, (const float*)a->in[0], WSP(bf16_t, WS_XN), WSP(u64_t, WS_SSQ));
    for (int i = c.bid * 512 + c.tid; i < 3 * M; i += c.G * 512) WSP(u64_t, WS_SSQ)[M + i] = 0ull;
    rope_table(c, (const int*)a->in[1], WSP(f32x2, WS_ROPE)); }
  cg::this_grid().sync();
  { CArgsP a = get_args(); (void)xcd_barrier_post((unsigned*)(a->ws + WS_BAR), (volatile LAS unsigned*)&xb_words); }
#define GBAR() do { CArgsP a_ = get_args(); XcdBarrier b_; b_.bar = (unsigned*)(a_->ws + WS_BAR); b_.x = xb_xcc_id(); b_.st = (volatile LAS unsigned*)&xb_words; xcd_barrier(b_); } while (0)
#pragma unroll 1
  for (int l = 0; l < DEPTH; ++l) {
    if (PH & 2) { CArgsP a = get_args(); Ctx c = mk_ctx(lds); unsigned char* wb = a->ws + WS_W + (size_t)l * LAYER_W;
      pg8::Gemm g{WSP(bf16_t, WS_XN), (const bf16_t*)(wb + W_IN_OFF), M, NIN, DM}; pg8::StaticOrder S; S.init(M, NIN, c.G, c.bid); pg8::EpiInProj E{WSP(float, WS_PA), WSP(bf16_t, WS_PB), WSP(u64_t, WS_SSQ) + (size_t)(2 * l) * M};
      pg8::gemm_phase<pg8::EpiInProj, pg8::StaticOrder, true, true>(c.lds, g, S, E); }
    GBAR();
    if (PH & 16) { CArgsP a = get_args(); Ctx c = mk_ctx(lds); hgrn_passA_mfma(c, WSP(float, WS_PA), (const float*)a->in[2], l, WSP(float, WS_HU), WSP(float, WS_HD)); }
    if (PH & 32) { CArgsP a = get_args(); Ctx c = mk_ctx(lds); s5_passA(c, a, l, WSP(float, WS_PA), WSP(f32x2, WS_XE)); }
    GBAR();
    if (PH & 64) { CArgsP a = get_args(); Ctx c = mk_ctx(lds);
      if (c.bid < 32) hgrn_scan(c, WSP(float, WS_HU), WSP(float, WS_HD), WSP(float, WS_HSIN)); else if (c.bid < 34) s5_scan(c, a, l, WSP(f32x2, WS_XE), WSP(f32x2, WS_XIN)); }
    if (PH & 4) { CArgsP a = get_args(); Ctx c = mk_ctx(lds); if (c.bid >= 34) { c.bid -= 34; c.G -= 34; prep_qk(c, WSP(bf16_t, WS_PB), WSP(f32x2, WS_ROPE), (const float*)a->in[16] + l * 64, (const float*)a->in[17] + l * 64); } }
    if (PH & 8) { CArgsP a = get_args(); Ctx c = mk_ctx(lds); if (c.bid >= 34) { c.bid -= 34; c.G -= 34; prep_vt(c, WSP(bf16_t, WS_PB), WSP(bf16_t, WS_VT)); } }
    GBAR();
    if (PH & 128) { CArgsP a = get_args(); Ctx c = mk_ctx(lds); attn_phase(c, a, l, WSP(bf16_t, WS_PB), WSP(bf16_t, WS_VT), WSP(bf16_t, WS_MIX)); }
    if (PH & 256) { CArgsP a = get_args(); Ctx c = mk_ctx(lds); hgrn_pass<true>(c, WSP(float, WS_PA), (const float*)a->in[2], l, nullptr, nullptr, WSP(float, WS_HSIN), (const float*)a->in[5] + l * 64, WSP(bf16_t, WS_MIX)); }
    if (PH & 512) { CArgsP a = get_args(); Ctx c = mk_ctx(lds); unsigned char* wb = a->ws + WS_W + (size_t)l * LAYER_W; s5_passB(c, a, l, WSP(float, WS_PA), WSP(f32x2, WS_XIN), (const bf16_t*)(wb + W_GLU_OFF), WSP(bf16_t, WS_MIX)); }
    GBAR();
    if (PH & 1024) { CArgsP a = get_args(); Ctx c = mk_ctx(lds); unsigned char* wb = a->ws + WS_W + (size_t)l * LAYER_W; const float* xin = (l == 0) ? (const float*)a->in[0] : (const float*)a->out;
      pg8::Gemm g{WSP(bf16_t, WS_MIX), (const bf16_t*)(wb + W_OUT_OFF), M, DM, DM}; pg8::StaticOrder S; S.init(M, DM, c.G, c.bid); pg8::EpiRes E{xin, a->out, WSP(bf16_t, WS_XN), WSP(u64_t, WS_SSQ) + (size_t)(2 * l + 1) * M};
      pg8::gemm_phase<pg8::EpiRes, pg8::StaticOrder, false, true>(c.lds, g, S, E); }
    GBAR();
    if (PH & 2048) { CArgsP a = get_args(); Ctx c = mk_ctx(lds); unsigned char* wb = a->ws + WS_W + (size_t)l * LAYER_W;
      pg8::Gemm g{WSP(bf16_t, WS_XN), (const bf16_t*)(wb + W_UP_OFF), M, DFF, DM}; pg8::StaticOrder S; S.init(M, DFF, c.G, c.bid); pg8::EpiRelu2 E{WSP(bf16_t, WS_H), WSP(u64_t, WS_SSQ) + (size_t)(2 * l + 1) * M};
      pg8::gemm_phase<pg8::EpiRelu2, pg8::StaticOrder, true, true>(c.lds, g, S, E); }
    GBAR();
    if (PH & 4096) { CArgsP a = get_args(); Ctx c = mk_ctx(lds); unsigned char* wb = a->ws + WS_W + (size_t)l * LAYER_W;
      pg8::Gemm g{WSP(bf16_t, WS_H), (const bf16_t*)(wb + W_DOWN_OFF), M, DM, DFF}; pg8::StaticOrder S; S.init(M, DM, c.G, c.bid); pg8::EpiRes E{a->out, a->out, (l + 1 < DEPTH) ? WSP(bf16_t, WS_XN) : (bf16_t*)nullptr, WSP(u64_t, WS_SSQ) + (size_t)(2 * l + 2 < 4 ? 2 * l + 2 : 0) * M};
      pg8::gemm_phase<pg8::EpiRes, pg8::StaticOrder, false, true>(c.lds, g, S, E); }
    GBAR();
  }
#undef WSP
}

extern "C" void kernel_launch(void* const* d_in, const int* in_sizes, int n_in, void* d_out, int out_size, void* d_ws, size_t ws_size, hipStream_t stream) {
  static int grid = 0; constexpr int LDSB = 65536 + 8 * 8448;
  if (grid == 0) {
    int dev = 0, cus = 0, per = 0;
    if (hipGetDevice(&dev) != hipSuccess || hipDeviceGetAttribute(&cus, hipDeviceAttributeMultiprocessorCount, dev) != hipSuccess) { fprintf(stderr, "device query failed\n"); grid = -1; return; }
    if (hipFuncSetAttribute((const void*)hymba_fwd, hipFuncAttributeMaxDynamicSharedMemorySize, LDSB) != hipSuccess) { fprintf(stderr, "hipFuncSetAttribute failed\n"); grid = -1; return; }
    if (hipOccupancyMaxActiveBlocksPerMultiprocessor(&per, (const void*)hymba_fwd, 512, LDSB) != hipSuccess || per < 1) fprintf(stderr, "occupancy query: %d\n", per);
    (void)hipGetLastError();
    grid = cus;
    if (n_in != 27 || ws_size < 256 * MiB) fprintf(stderr, "unexpected n_in %d / ws_size %zu\n", n_in, ws_size);
  }
  if (grid < 0) return;
  Args a{};
  for (int i = 0; i < 27; ++i) a.in[i] = d_in[i];
  a.out = (float*)d_out; a.ws = (unsigned char*)d_ws;
  void* args[] = {&a};
  hipError_t e = hipLaunchCooperativeKernel((const void*)hymba_fwd, dim3(grid), dim3(512), args, LDSB, stream);
  if (e != hipSuccess) fprintf(stderr, "cooperative launch failed: %s (grid %d)\n", hipGetErrorString(e), grid);
}
```

```cpp
#include <hip/hip_runtime.h>
#include <hip/hip_cooperative_groups.h>
#include <cstdio>
#include <cstdint>
namespace cg = cooperative_groups;

__shared__ unsigned g_wtab[64];
__device__ __forceinline__ unsigned hw_slot() { return (unsigned)__builtin_amdgcn_s_getreg((6 << 11) | 4) & 63u; }
__shared__ unsigned g_simdcnt[4];
__device__ __forceinline__ int my_stagger() { return (__builtin_amdgcn_readfirstlane((int)((volatile __attribute__((address_space(3))) unsigned*)g_wtab)[hw_slot()]) >> 8) & 1; }
__device__ __forceinline__ int my_tid() {
  int lane = (int)__builtin_amdgcn_mbcnt_hi(~0u, __builtin_amdgcn_mbcnt_lo(~0u, 0u)); asm volatile("" : "+v"(lane));
  const int wave = __builtin_amdgcn_readfirstlane((int)((volatile __attribute__((address_space(3))) unsigned*)g_wtab)[hw_slot()]) & 0xff;
  return wave * 64 + lane;
}
#ifndef PH
#define PH 0x1fff
#endif
namespace pg8 {
#define PG8_LAS __attribute__((address_space(3)))
typedef unsigned short bf16_t;
typedef short bf16x8 __attribute__((ext_vector_type(8)));
typedef float f32x4 __attribute__((ext_vector_type(4)));
typedef unsigned u32x4 __attribute__((ext_vector_type(4)));
constexpr int BM = 256, BK = 64, HALF = 128, HTB = HALF * BK * 2  , STAGE_BYTES = 8 * HTB, NXCD = 8, WGM = 8;

__host__ __device__ __forceinline__ int lds_byte(int r, int c) { const int st = (r >> 4) * 2 + (c >> 5), rr = r & 15, cc = c & 31, ob = rr * 64 + cc * 2; return st * 1024 + (ob ^ (((ob >> 9) & 1) << 5)); }
__host__ __device__ __forceinline__ void stage_rc(int b, int& R, int& C) { const int st = b / 1024, sb = b % 1024, swz = sb ^ (((sb >> 9) & 1) << 5); R = (st >> 1) * 16 + swz / 64; C = (st & 1) * 32 + (swz % 64) / 2; }
__host__ __device__ __forceinline__ int perm32(int rho) { const int n = rho >> 4, i = rho & 15; return 8 * (i >> 2) + 4 * n + (i & 3); }

struct Unit { int pm, pn; };
struct Gemm { const bf16_t* A; const bf16_t* Bt; int M, N, K; };

struct StaticOrder {
    int nM, nN, nwg, G, c;
    __host__ __device__ void init(int M, int N, int G_, int c_) { nM = M / BM; nN = N / BM; nwg = nM * nN; G = G_; c = c_; }
    __host__ __device__ bool next(int i, Unit& u) const {
        const long L = (long)i * G + c; if (L >= nwg) return false;
        int wgid = (int)L; { const int q = nwg / NXCD, r = nwg % NXCD, xcd = wgid % NXCD, off = wgid / NXCD; wgid = (xcd < r ? xcd * (q + 1) : r * (q + 1) + (xcd - r) * q) + off; }
        const int nig = WGM * nN, gid = wgid / nig, fm = gid * WGM, gsz = (nM - fm) < WGM ? (nM - fm) : WGM;
        u.pm = fm + ((wgid % nig) % gsz); u.pn = (wgid % nig) / gsz; return true;
    }
    __device__ __forceinline__ void a_ready(const Unit&) const {}
    __device__ __forceinline__ void done(const Unit&) const {}
};

template <class Epi, class Sched, bool ALIGN_EPI = false, bool SP2 = false>
__device__ __forceinline__ void gemm_phase(PG8_LAS unsigned char* lds, const Gemm g, const Sched& S, const Epi& E) {
    int tid_ = my_tid();
    const int tid = tid_, wid = __builtin_amdgcn_readfirstlane(tid >> 6), lane = tid & 63, wr = wid >> 2, wc = wid & 3, fr = lane & 15, fq = lane >> 4;
    const int K = g.K, nt = K / BK;
    unsigned voffA[2], voffB[2];
#pragma unroll
    for (int i = 0; i < 2; ++i) { int R, C; stage_rc(tid * 16 + i * 8192, R, C); const int Rb = Epi::PERM ? ((R & ~31) + perm32(R & 31)) : R;
        voffA[i] = (unsigned)(R * K + C) * 2u; voffB[i] = (unsigned)(Rb * K + C) * 2u; }
    const size_t kstep = (size_t)(BK * 2);
    const size_t hstep = (size_t)HALF * K * 2;
    const size_t tstep = 2 * hstep;
    const unsigned ldsw = (unsigned)wid * 1024u;
    const int aoff = lds_byte(wr * 64 + fr, fq * 8), boff = lds_byte(wc * 32 + fr, fq * 8);
#define PG8_SA(b, h) (((b) * 2 + (h)) * HTB)
#define PG8_SB(b, h) ((4 + (b) * 2 + (h)) * HTB)
#define PG8_STAGE(bufoff, gbase, voff) do { _Pragma("unroll") for (int _i = 0; _i < 2; ++_i) \
        __builtin_amdgcn_global_load_lds((const unsigned*)((const char*)(gbase) + (voff)[_i]), (PG8_LAS unsigned*)(lds + (bufoff) + ldsw + _i * 8192), 16, 0, 0); } while (0)
#define PG8_LDA(dst, b, h) do { _Pragma("unroll") for (int m = 0; m < 4; ++m) _Pragma("unroll") for (int k = 0; k < 2; ++k) dst[m][k] = *(const PG8_LAS bf16x8*)(lds + PG8_SA(b, h) + aoff + m * 2048 + k * 1024); } while (0)
#define PG8_LDB(dst, b, h) do { _Pragma("unroll") for (int n = 0; n < 2; ++n) _Pragma("unroll") for (int k = 0; k < 2; ++k) dst[n][k] = *(const PG8_LAS bf16x8*)(lds + PG8_SB(b, h) + boff + n * 2048 + k * 1024); } while (0)
#define PG8_MMA(ai, bj, At, Bt) do { __builtin_amdgcn_s_setprio(1); _Pragma("unroll") for (int m = 0; m < 4; ++m) _Pragma("unroll") for (int n = 0; n < 2; ++n) _Pragma("unroll") for (int k = 0; k < 2; ++k) \
        acc[ai][bj][m][n] = __builtin_amdgcn_mfma_f32_16x16x32_bf16(Bt[n][k], At[m][k], acc[ai][bj][m][n], 0, 0, 0); __builtin_amdgcn_s_setprio(0); } while (0)
#define PG8_WAIT_V(n) asm volatile("s_waitcnt vmcnt(" #n ")" ::: "memory")
#define PG8_WAIT_L(n) asm volatile("s_waitcnt lgkmcnt(" #n ")" ::: "memory")
#define PG8_BAR __builtin_amdgcn_s_barrier()
#define PG8_SCHED __builtin_amdgcn_sched_barrier(0)
    Unit cur, nxt; int ui = 0;
    if (!S.next(0, cur)) return;
    f32x4 acc[2][2][4][2];
#pragma unroll
    for (int a = 0; a < 2; ++a)
#pragma unroll
        for (int b = 0; b < 2; ++b)
#pragma unroll
            for (int m = 0; m < 4; ++m)
#pragma unroll
                for (int n = 0; n < 2; ++n) acc[a][b][m][n] = (f32x4){0.f, 0.f, 0.f, 0.f};
    bf16x8 At[4][2], B0[2][2], B1[2][2];
    const char* cA = (const char*)g.A + (size_t)cur.pm * tstep; const char* cB = (const char*)g.Bt + (size_t)cur.pn * tstep;
    S.a_ready(cur);
    if constexpr (SP2) {
        PG8_STAGE(PG8_SB(0, 0), cB, voffB); PG8_STAGE(PG8_SB(0, 1), cB + hstep, voffB); PG8_STAGE(PG8_SA(0, 0), cA, voffA); PG8_STAGE(PG8_SA(0, 1), cA + hstep, voffA);
        if (wr == 1) PG8_BAR;
        PG8_WAIT_V(2); PG8_BAR;
        PG8_STAGE(PG8_SB(1, 0), cB + kstep, voffB); PG8_STAGE(PG8_SA(1, 0), cA + kstep, voffA); PG8_STAGE(PG8_SB(1, 1), cB + hstep + kstep, voffB);
        PG8_WAIT_V(6); PG8_BAR;
    } else {
        PG8_STAGE(PG8_SB(0, 0), cB, voffB); PG8_STAGE(PG8_SA(0, 0), cA, voffA); PG8_STAGE(PG8_SB(0, 1), cB + hstep, voffB); PG8_STAGE(PG8_SA(0, 1), cA + hstep, voffA);
        if (wr == 1) PG8_BAR;
        PG8_WAIT_V(4); PG8_BAR;
        PG8_STAGE(PG8_SB(1, 0), cB + kstep, voffB); PG8_STAGE(PG8_SA(1, 0), cA + kstep, voffA); PG8_STAGE(PG8_SB(1, 1), cB + hstep + kstep, voffB);
        PG8_WAIT_V(6); PG8_BAR;
    }
    for (;;) {
        const bool has_next = S.next(ui + 1, nxt);
        const char* nA = has_next ? (const char*)g.A + (size_t)nxt.pm * tstep : cA; const char* nB = has_next ? (const char*)g.Bt + (size_t)nxt.pn * tstep : cB;
        for (int t = 0; t < nt; t += 2) {
            const bool last = (t == nt - 2);
            const char* a1 = cA + (size_t)(t + 1) * kstep;
            const char* a2 = last ? nA : cA + (size_t)(t + 2) * kstep; const char* b2 = last ? nB : cB + (size_t)(t + 2) * kstep;
            const char* a3 = a2 + kstep; const char* b3 = b2 + kstep;
            if (last && has_next) S.a_ready(nxt);
            if constexpr (SP2) {
            PG8_LDB(B0, 0, 0); PG8_LDB(B1, 0, 1); PG8_SCHED; PG8_LDA(At, 0, 0); PG8_STAGE(PG8_SA(1, 1), a1 + hstep, voffA);
            PG8_WAIT_V(8); PG8_WAIT_L(0); PG8_BAR; PG8_MMA(0, 0, At, B0); PG8_MMA(0, 1, At, B1); PG8_BAR; PG8_SCHED;
            PG8_LDA(At, 0, 1); PG8_STAGE(PG8_SB(0, 0), b2, voffB); PG8_STAGE(PG8_SB(0, 1), b2 + hstep, voffB); PG8_STAGE(PG8_SA(0, 0), a2, voffA);
            PG8_WAIT_V(8); PG8_WAIT_L(0); PG8_BAR; PG8_MMA(1, 0, At, B0); PG8_MMA(1, 1, At, B1); PG8_BAR; PG8_SCHED;
            PG8_LDB(B0, 1, 0); PG8_LDB(B1, 1, 1); PG8_SCHED; PG8_LDA(At, 1, 0); PG8_STAGE(PG8_SA(0, 1), a2 + hstep, voffA);
            PG8_WAIT_V(8); PG8_WAIT_L(0); PG8_BAR; PG8_MMA(0, 0, At, B0); PG8_MMA(0, 1, At, B1); PG8_BAR; PG8_SCHED;
            PG8_LDA(At, 1, 1); PG8_STAGE(PG8_SB(1, 0), b3, voffB); PG8_STAGE(PG8_SB(1, 1), b3 + hstep, voffB); PG8_STAGE(PG8_SA(1, 0), a3, voffA);
            PG8_WAIT_V(8); PG8_WAIT_L(0); PG8_BAR; PG8_MMA(1, 0, At, B0); PG8_MMA(1, 1, At, B1); PG8_BAR; PG8_SCHED;
            } else {
            PG8_LDB(B0, 0, 0); PG8_SCHED; PG8_LDA(At, 0, 0); PG8_STAGE(PG8_SA(1, 1), a1 + hstep, voffA);
            PG8_WAIT_L(8); PG8_BAR; PG8_WAIT_L(0); PG8_MMA(0, 0, At, B0); PG8_BAR; PG8_SCHED;
            PG8_LDB(B1, 0, 1); PG8_STAGE(PG8_SB(0, 0), b2, voffB);
            PG8_BAR; PG8_WAIT_L(0); PG8_MMA(0, 1, At, B1); PG8_BAR;
            PG8_LDA(At, 0, 1); PG8_STAGE(PG8_SA(0, 0), a2, voffA);
            PG8_BAR; PG8_WAIT_L(0); PG8_MMA(1, 0, At, B0); PG8_BAR; PG8_SCHED;
            PG8_STAGE(PG8_SB(0, 1), b2 + hstep, voffB);
            PG8_WAIT_V(6); PG8_BAR; PG8_MMA(1, 1, At, B1); PG8_BAR;
            PG8_LDB(B0, 1, 0); PG8_SCHED; PG8_LDA(At, 1, 0); PG8_STAGE(PG8_SA(0, 1), a2 + hstep, voffA);
            PG8_WAIT_L(8); PG8_BAR; PG8_WAIT_L(0); PG8_MMA(0, 0, At, B0); PG8_BAR; PG8_SCHED;
            PG8_LDB(B1, 1, 1); PG8_STAGE(PG8_SB(1, 0), b3, voffB);
            PG8_BAR; PG8_WAIT_L(0); PG8_MMA(0, 1, At, B1); PG8_BAR;
            PG8_LDA(At, 1, 1); PG8_STAGE(PG8_SA(1, 0), a3, voffA);
            PG8_BAR; PG8_WAIT_L(0); PG8_MMA(1, 0, At, B0); PG8_BAR; PG8_SCHED;
            PG8_STAGE(PG8_SB(1, 1), b3 + hstep, voffB);
            PG8_WAIT_V(6); PG8_BAR; PG8_MMA(1, 1, At, B1); PG8_BAR;
            }
        }
        if constexpr (ALIGN_EPI) { if (wr == 0) PG8_BAR; }
        if constexpr (!Epi::AFTER_DRAIN) { E(acc, cur, wr, wc, fr, fq); S.done(cur); }
        if (!has_next) break;
#pragma unroll
        for (int a = 0; a < 2; ++a)
#pragma unroll
            for (int b = 0; b < 2; ++b)
#pragma unroll
                for (int m = 0; m < 4; ++m)
#pragma unroll
                    for (int n = 0; n < 2; ++n) acc[a][b][m][n] = (f32x4){0.f, 0.f, 0.f, 0.f};
        cur = nxt; cA = nA; cB = nB; ++ui;
        if constexpr (ALIGN_EPI) { if (wr == 1) PG8_BAR; }
    }
    PG8_WAIT_V(0);
    if constexpr (!ALIGN_EPI) { if (wr == 0) PG8_BAR; }
    PG8_BAR;
    if constexpr (Epi::AFTER_DRAIN) { E.fused(acc, cur, wr, wc, fr, fq, lds, wid, lane); S.done(cur); }
#undef PG8_SA
#undef PG8_SB
#undef PG8_STAGE
#undef PG8_LDA
#undef PG8_LDB
#undef PG8_MMA
#undef PG8_WAIT_V
#undef PG8_WAIT_L
#undef PG8_BAR
#undef PG8_SCHED
}
}

#define LAS __attribute__((address_space(3)))
#define DI __device__ __forceinline__
typedef unsigned short bf16_t;
typedef short bf16x8 __attribute__((ext_vector_type(8)));
typedef float f32x4 __attribute__((ext_vector_type(4)));
typedef float f32x2 __attribute__((ext_vector_type(2)));
typedef float f32x16 __attribute__((ext_vector_type(16)));
typedef unsigned u32x4 __attribute__((ext_vector_type(4)));
typedef unsigned u32x2 __attribute__((ext_vector_type(2)));
typedef __bf16 bf16x2v __attribute__((ext_vector_type(2)));

constexpr int M = 16384, DM = 1024, NIN = 2816, DFF = 4096, DEPTH = 2;
constexpr int PA_W = 1280, PB_W = 1536;
constexpr float EPS = 1e-6f, LOG2E = 1.4426950408889634f;
constexpr size_t MiB = 1048576;
constexpr size_t W_IN_OFF = 0, W_OUT_OFF = (size_t)NIN * DM * 2, W_UP_OFF = W_OUT_OFF + (size_t)DM * DM * 2, W_DOWN_OFF = W_UP_OFF + (size_t)DFF * DM * 2,
                 W_GLU_OFF = W_DOWN_OFF + (size_t)DM * DFF * 2, LAYER_W = W_GLU_OFF + 256 * 256 * 2;
static_assert(2 * LAYER_W <= 48 * MiB, "weights");
constexpr size_t WS_W = 0, WS_XN = 48 * MiB, WS_MIX = 80 * MiB, WS_PA = 112 * MiB, WS_PB = 192 * MiB, WS_H = 112 * MiB, WS_SMALL = 240 * MiB;
constexpr size_t WS_VT = WS_XN, WS_HU = WS_XN + 16 * MiB, WS_HSIN = WS_XN + 24 * MiB;
constexpr size_t WS_HD = WS_SMALL, WS_XE = WS_SMALL + 1 * MiB, WS_XIN = WS_SMALL + 3 * MiB, WS_BAR = WS_SMALL + 5 * MiB, WS_ROPE = WS_SMALL + 6 * MiB, WS_SSQ = WS_SMALL + 10 * MiB;
typedef unsigned long long u64_t;
constexpr float SSQ_SCALE = 1048576.f;
DI u64_t ssq_fix(float s) { return (u64_t)(s * SSQ_SCALE + 0.5f); }
DI float row_rstd(const u64_t* p) { const float s = (float)(*p) * (1.f / SSQ_SCALE); return 1.f / sqrtf(s * (1.f / 1024.f) + 1e-6f); }

struct Args { const void* in[27]; float* out; unsigned char* ws; };
struct Ctx { LAS unsigned char* lds; int tid, lane, wave, G, bid; };
typedef const __attribute__((address_space(4))) Args* CArgsP;
DI CArgsP get_args() { CArgsP p = (CArgsP)__builtin_amdgcn_kernarg_segment_ptr(); asm volatile("" : "+s"(p)); return p; }
DI Ctx mk_ctx(LAS unsigned char* lds) { Ctx c; int t = my_tid(); c.lds = lds; c.tid = t; c.lane = t & 63; c.wave = __builtin_amdgcn_readfirstlane(t >> 6); c.G = gridDim.x; c.bid = blockIdx.x; return c; }

DI unsigned pk2(float a, float b) { f32x2 v = {a, b}; bf16x2v r = __builtin_convertvector(v, bf16x2v); return __builtin_bit_cast(unsigned, r); }
DI bf16_t f2bf(float a) { return (bf16_t)(pk2(a, 0.f) & 0xffffu); }
DI float bf2f(bf16_t a) { return __uint_as_float(((unsigned)a) << 16); }
DI float wave_sum(float v) {
#pragma unroll
  for (int o = 1; o < 64; o <<= 1) v += __shfl_xor(v, o);
  return v;
}
DI float wave_max(float v) {
#pragma unroll
  for (int o = 1; o < 64; o <<= 1) v = fmaxf(v, __shfl_xor(v, o));
  return v;
}

DI float dpp_xor1(float v) { return __int_as_float(__builtin_amdgcn_mov_dpp(__float_as_int(v), 0xB1, 0xF, 0xF, true)); }
DI float dpp_xor2(float v) { return __int_as_float(__builtin_amdgcn_mov_dpp(__float_as_int(v), 0x4E, 0xF, 0xF, true)); }
DI float dpp_hmirror(float v) { return __int_as_float(__builtin_amdgcn_mov_dpp(__float_as_int(v), 0x141, 0xF, 0xF, true)); }
DI float sigmoidf_(float x) { return 1.f / (1.f + __expf(-x)); }
DI void wg_sync() { __syncthreads(); }


#define XB_TMO      128
#define XB_XCNT(j)  (256  + 64 * (j))
#define XB_XSUB(j)  (1280 + 64 * (j))
#define XB_XGEN(j)  (2304 + 64 * (j))
#define XB_TOP      3328
#define XB_TOPGEN   3392
#define XCD_BAR_WORDS 3456
#define XB_SPIN_CAP (1u << 18)
__device__ __forceinline__ unsigned xb_ld(unsigned* p)              { return __hip_atomic_load(p, __ATOMIC_RELAXED, __HIP_MEMORY_SCOPE_AGENT); }
__device__ __forceinline__ unsigned xb_add(unsigned* p, unsigned v) { return __hip_atomic_fetch_add(p, v, __ATOMIC_RELAXED, __HIP_MEMORY_SCOPE_AGENT); }
__device__ __forceinline__ unsigned xb_xcc_id() { return (unsigned)__builtin_amdgcn_s_getreg((3 << 11) | 20) & 0xFu; }
#define XB_SPIN(cond, bar) do { unsigned _sp = 0; while (cond) { __builtin_amdgcn_s_sleep(1); \
    if ((++_sp & 255u) == 0u) { if (xb_ld(&(bar)[XB_TMO])) break; if (_sp > XB_SPIN_CAP) { atomicAdd(&(bar)[XB_TMO], 1u); break; } } } } while (0)
struct XcdBarrier { unsigned* bar; unsigned x; volatile LAS unsigned* st; };
__device__ __forceinline__ XcdBarrier xcd_barrier_post(unsigned* bar, volatile LAS unsigned* st) {
    XcdBarrier b; b.bar = bar; b.x = xb_xcc_id(); b.st = st;
    if (my_tid() == 0) (void)xb_add(&bar[XB_XCNT(b.x)], 1u);
    return b;
}
__device__ __forceinline__ void xcd_barrier_complete(unsigned* bar, unsigned x, unsigned& nloc, unsigned& nx) {
    const unsigned G = gridDim.x * gridDim.y * gridDim.z;
    unsigned sum, cnt, mine, sp = 0u;
    for (;;) {
        sum = 0u; cnt = 0u; mine = 0u;
#pragma unroll
        for (unsigned j = 0; j < 16; ++j) { const unsigned c = xb_ld(&bar[XB_XCNT(j)]); sum += c; cnt += (c > 0u) ? 1u : 0u; mine = (j == x) ? c : mine; }
        if (sum == G) break;
        __builtin_amdgcn_s_sleep(1);
        if ((++sp & 255u) == 0u) { if (xb_ld(&bar[XB_TMO])) break; if (sp > XB_SPIN_CAP) { atomicAdd(&bar[XB_TMO], 1u); break; } }
    }
    nloc = mine > 0u ? mine : 1u; nx = cnt > 0u ? cnt : 1u;
}
__device__ __forceinline__ void xcd_barrier(const XcdBarrier& b) {
    asm volatile("s_waitcnt vmcnt(0)" ::: "memory");
    __syncthreads();
    if (my_tid() == 0) {
        unsigned* bar = b.bar;
        __builtin_amdgcn_s_waitcnt(0);
        unsigned nloc = b.st[0], nx = b.st[1];
        if (nloc == 0u) { xcd_barrier_complete(bar, b.x, nloc, nx); b.st[0] = nloc; b.st[1] = nx; }
        const unsigned old = xb_add(&bar[XB_XSUB(b.x)], 1u);
        const unsigned gen = old / nloc;
        if (old + 1u == (gen + 1u) * nloc) {
            __builtin_amdgcn_fence(__ATOMIC_RELEASE, "agent");
            asm volatile("s_waitcnt vmcnt(0)" ::: "memory");
            const unsigned og = xb_add(&bar[XB_TOP], 1u);
            const unsigned tg = og / nx;
            if (og + 1u == (tg + 1u) * nx) xb_add(&bar[XB_TOPGEN], 1u);
            else XB_SPIN(xb_ld(&bar[XB_TOPGEN]) == tg, bar);
            __builtin_amdgcn_fence(__ATOMIC_ACQUIRE, "agent");
            xb_add(&bar[XB_XGEN(b.x)], 1u);
            asm volatile("s_waitcnt vmcnt(0)" ::: "memory");
        } else {
            XB_SPIN(xb_ld(&bar[XB_XGEN(b.x)]) == gen, bar);
            __builtin_amdgcn_fence(__ATOMIC_ACQUIRE, "agent");
            asm volatile("s_waitcnt vmcnt(0)" ::: "memory");
        }
    }
    __syncthreads();
}

namespace pg8 {
struct EpiInProj {
  static constexpr bool PERM = true, AFTER_DRAIN = false;
  float* PA; bf16_t* PB; const u64_t* ssq;
  __device__ __forceinline__ void operator()(const f32x4 (&acc_)[2][2][4][2], const Unit& u, int wr, int wc, int fr, int fq) const {
    const int row0 = u.pm * BM + wr * 64 + fr;
    f32x4 acc[2][2][4][2];
#pragma unroll
    for (int ai = 0; ai < 2; ++ai)
#pragma unroll
      for (int m = 0; m < 4; ++m) { const float rs = row_rstd(ssq + row0 + ai * HALF + m * 16);
#pragma unroll
        for (int bj = 0; bj < 2; ++bj) { acc[ai][bj][m][0] = acc_[ai][bj][m][0] * rs; acc[ai][bj][m][1] = acc_[ai][bj][m][1] * rs; } }
    if (u.pn < 5) {
      const int col0 = u.pn * BM + wc * 32 + 8 * fq;
#pragma unroll
      for (int ai = 0; ai < 2; ++ai)
#pragma unroll
        for (int m = 0; m < 4; ++m) { float* rowp = PA + (size_t)(row0 + ai * HALF + m * 16) * PA_W + col0;
#pragma unroll
          for (int bj = 0; bj < 2; ++bj) { *(f32x4*)(rowp + bj * HALF) = acc[ai][bj][m][0]; *(f32x4*)(rowp + bj * HALF + 4) = acc[ai][bj][m][1]; } }
    } else {
      const int col0 = (u.pn - 5) * BM + wc * 32 + 8 * fq;
#pragma unroll
      for (int ai = 0; ai < 2; ++ai)
#pragma unroll
        for (int m = 0; m < 4; ++m) { bf16_t* rowp = PB + (size_t)(row0 + ai * HALF + m * 16) * PB_W + col0;
#pragma unroll
          for (int bj = 0; bj < 2; ++bj) { const f32x4 v0 = acc[ai][bj][m][0], v1 = acc[ai][bj][m][1]; u32x4 w;
            w.x = pk2(v0[0], v0[1]); w.y = pk2(v0[2], v0[3]); w.z = pk2(v1[0], v1[1]); w.w = pk2(v1[2], v1[3]); *(u32x4*)(rowp + bj * HALF) = w; } }
    }
  }
};
struct EpiRes {
  static constexpr bool PERM = true, AFTER_DRAIN = false;
  const float* res; float* out; bf16_t* xb; u64_t* ssq;
  __device__ __forceinline__ void operator()(const f32x4 (&acc)[2][2][4][2], const Unit& u, int wr, int wc, int fr, int fq) const {
    const int row0 = u.pm * BM + wr * 64 + fr, col0 = u.pn * BM + wc * 32 + 8 * fq;
#pragma unroll
    for (int ai = 0; ai < 2; ++ai)
#pragma unroll
      for (int m = 0; m < 4; ++m) { const size_t off = (size_t)(row0 + ai * HALF + m * 16) * DM + col0; float ss = 0.f;
#pragma unroll
        for (int bj = 0; bj < 2; ++bj) { const f32x4 r0 = *(const f32x4*)(res + off + bj * HALF), r1 = *(const f32x4*)(res + off + bj * HALF + 4);
          const f32x4 v0 = r0 + acc[ai][bj][m][0], v1 = r1 + acc[ai][bj][m][1];
          *(f32x4*)(out + off + bj * HALF) = v0; *(f32x4*)(out + off + bj * HALF + 4) = v1;
          if (xb) { u32x4 w; w.x = pk2(v0[0], v0[1]); w.y = pk2(v0[2], v0[3]); w.z = pk2(v1[0], v1[1]); w.w = pk2(v1[2], v1[3]); *(u32x4*)(xb + off + bj * HALF) = w;
            ss += (v0[0] * v0[0] + v0[1] * v0[1]) + (v0[2] * v0[2] + v0[3] * v0[3]) + (v1[0] * v1[0] + v1[1] * v1[1]) + (v1[2] * v1[2] + v1[3] * v1[3]); } }
        if (xb) { ss += __shfl_xor(ss, 16); ss += __shfl_xor(ss, 32); if (fq == 0) atomicAdd(ssq + row0 + ai * HALF + m * 16, ssq_fix(ss)); } }
  }
};
struct EpiRelu2 {
  static constexpr bool PERM = true, AFTER_DRAIN = false;
  bf16_t* H; const u64_t* ssq;
  __device__ __forceinline__ void operator()(const f32x4 (&acc)[2][2][4][2], const Unit& u, int wr, int wc, int fr, int fq) const {
    const int row0 = u.pm * BM + wr * 64 + fr, col0 = u.pn * BM + wc * 32 + 8 * fq;
#pragma unroll
    for (int ai = 0; ai < 2; ++ai)
#pragma unroll
      for (int m = 0; m < 4; ++m) { bf16_t* rowp = H + (size_t)(row0 + ai * HALF + m * 16) * DFF + col0; const float rs = row_rstd(ssq + row0 + ai * HALF + m * 16);
#pragma unroll
        for (int bj = 0; bj < 2; ++bj) { f32x4 v0 = acc[ai][bj][m][0], v1 = acc[ai][bj][m][1];
#pragma unroll
          for (int e = 0; e < 4; ++e) { const float a = fmaxf(v0[e], 0.f) * rs, b = fmaxf(v1[e], 0.f) * rs; v0[e] = a * a; v1[e] = b * b; }
          u32x4 w; w.x = pk2(v0[0], v0[1]); w.y = pk2(v0[2], v0[3]); w.z = pk2(v1[0], v1[1]); w.w = pk2(v1[2], v1[3]); *(u32x4*)(rowp + bj * HALF) = w; } }
  }
};
}
DI void transpose_item(const float* W, const float* gain, int K, int N, bf16_t* WT, LAS float* scr, int item, int lane) {
  const int nblk = N / 32, kb = item / nblk, nb = item % nblk, k0 = 64 * kb, n0 = 32 * nb;
#pragma unroll 8
  for (int i = 0; i < 32; ++i) { const int kk = 2 * i + (lane >> 5); const float gsc = gain ? gain[k0 + kk] : 1.f;
    scr[kk * 33 + (lane & 31)] = W[(size_t)(k0 + kk) * N + n0 + (lane & 31)] * gsc; }
  asm volatile("s_waitcnt lgkmcnt(0)" ::: "memory");
  const int c = lane & 7;
#pragma unroll
  for (int j = 0; j < 4; ++j) { const int n = (lane >> 3) + 8 * j; const LAS float* s = scr + (8 * c) * 33 + n;
    u32x4 o; o.x = pk2(s[0 * 33], s[1 * 33]); o.y = pk2(s[2 * 33], s[3 * 33]); o.z = pk2(s[4 * 33], s[5 * 33]); o.w = pk2(s[6 * 33], s[7 * 33]);
    *(u32x4*)(WT + (size_t)(n0 + n) * K + k0 + 8 * c) = o; }
  asm volatile("s_waitcnt lgkmcnt(0)" ::: "memory");
}
DI void prologue_weights(const Ctx& c, CArgsP a) {
  LAS float* scr = (LAS float*)(c.lds + c.wave * 16384);
  const int gw = c.bid * 8 + c.wave, NGW = c.G * 8;
  constexpr int I_IN = (DM / 64) * (NIN / 32), I_OUT = (DM / 64) * (DM / 32), I_UP = (DM / 64) * (DFF / 32), I_DN = (DFF / 64) * (DM / 32), I_GL = (256 / 64) * (256 / 32);
  constexpr int PER = I_IN + I_OUT + I_UP + I_DN + I_GL;
  for (int it = gw; it < DEPTH * PER; it += NGW) {
    const int l = it / PER; int r = it % PER;
    unsigned char* wb = a->ws + WS_W + (size_t)l * LAYER_W;
    if (r < I_IN) { transpose_item((const float*)a->in[4] + (size_t)l * DM * NIN, (const float*)a->in[3] + l * DM, DM, NIN, (bf16_t*)(wb + W_IN_OFF), scr, r, c.lane); continue; } r -= I_IN;
    if (r < I_OUT) { transpose_item((const float*)a->in[23] + (size_t)l * DM * DM, nullptr, DM, DM, (bf16_t*)(wb + W_OUT_OFF), scr, r, c.lane); continue; } r -= I_OUT;
    if (r < I_UP) { transpose_item((const float*)a->in[25] + (size_t)l * DM * DFF, (const float*)a->in[24] + l * DM, DM, DFF, (bf16_t*)(wb + W_UP_OFF), scr, r, c.lane); continue; } r -= I_UP;
    if (r < I_DN) { transpose_item((const float*)a->in[26] + (size_t)l * DFF * DM, nullptr, DFF, DM, (bf16_t*)(wb + W_DOWN_OFF), scr, r, c.lane); continue; } r -= I_DN;
    transpose_item((const float*)a->in[14] + (size_t)l * 256 * 256, nullptr, 256, 256, (bf16_t*)(wb + W_GLU_OFF), scr, r, c.lane);
  }
}
DI void convert_rows(const Ctx& c, const float* x, bf16_t* xn, u64_t* ssq) {
  const int gw = c.bid * 8 + c.wave, NGW = c.G * 8;
  for (int m = gw; m < M; m += NGW) {
    const f32x4* xr = (const f32x4*)(x + (size_t)m * DM) + c.lane;
    f32x4 v[4]; float s = 0.f;
#pragma unroll
    for (int j = 0; j < 4; ++j) { v[j] = xr[64 * j]; s += (v[j].x * v[j].x + v[j].y * v[j].y) + (v[j].z * v[j].z + v[j].w * v[j].w); }
    s = wave_sum(s);
    if (c.lane == 0) ssq[m] = ssq_fix(s);
    unsigned long long* o8 = (unsigned long long*)(xn + (size_t)m * DM) + c.lane;
#pragma unroll
    for (int j = 0; j < 4; ++j) o8[64 * j] = (unsigned long long)pk2(v[j].x, v[j].y) | ((unsigned long long)pk2(v[j].z, v[j].w) << 32);
  }
}

DI void rope_table(const Ctx& c, const int* pos, f32x2* tab) {
  for (int i = c.bid * 512 + c.tid; i < M * 32; i += c.G * 512) { const int t = i >> 5, j = i & 31;
    const float inv_freq = powf(10000.f, -(float)(2 * j) / 64.f); const float ang = (float)pos[t] * inv_freq; float sn, cs; sincosf(ang, &sn, &cs);
    tab[i] = (f32x2){cs, sn}; }
}
DI void prep_qk(const Ctx& c, bf16_t* PB, const f32x2* tab, const float* gq, const float* gk) {
  const int gw = c.bid * 8 + c.wave, NGW = c.G * 8;
  const int sgi = c.lane >> 2, c4 = c.lane & 3;
  const float* gain = (sgi >= 8) ? gk : gq; const float scale = (sgi >= 8) ? 1.f : 0.125f * LOG2E;
  float g1[8], g2[8];
#pragma unroll
  for (int e = 0; e < 8; ++e) { g1[e] = gain[8 * c4 + e] * scale; g2[e] = gain[8 * c4 + 32 + e] * scale; }
#pragma unroll 2
  for (int row = gw; row < M; row += NGW) {
    bf16_t* base = PB + (size_t)row * PB_W + sgi * 64 + 8 * c4;
    const u32x4 a = *(const u32x4*)base, b = *(const u32x4*)(base + 32);
    const f32x4* tp = (const f32x4*)(tab + (size_t)row * 32 + 8 * c4);
    const f32x4 r0 = tp[0], r1 = tp[1], r2 = tp[2], r3 = tp[3];
    const float cs[8] = {r0.x, r0.z, r1.x, r1.z, r2.x, r2.z, r3.x, r3.z}, sn[8] = {r0.y, r0.w, r1.y, r1.w, r2.y, r2.w, r3.y, r3.w};
    float t1[8], t2[8]; float ss = 0.f;
#pragma unroll
    for (int e = 0; e < 4; ++e) { t1[2 * e] = __uint_as_float(a[e] << 16); t1[2 * e + 1] = __uint_as_float(a[e] & 0xffff0000u); t2[2 * e] = __uint_as_float(b[e] << 16); t2[2 * e + 1] = __uint_as_float(b[e] & 0xffff0000u); }
#pragma unroll
    for (int e = 0; e < 8; ++e) ss += t1[e] * t1[e] + t2[e] * t2[e];
    ss += dpp_xor1(ss); ss += dpp_xor2(ss);
    const float r = 1.f / sqrtf(ss * (1.f / 64.f) + EPS);
    u32x4 oa, ob;
#pragma unroll
    for (int e = 0; e < 4; ++e) {
      const float x1a = t1[2 * e] * r * g1[2 * e], x2a = t2[2 * e] * r * g2[2 * e], x1b = t1[2 * e + 1] * r * g1[2 * e + 1], x2b = t2[2 * e + 1] * r * g2[2 * e + 1];
      oa[e] = pk2(x1a * cs[2 * e] - x2a * sn[2 * e], x1b * cs[2 * e + 1] - x2b * sn[2 * e + 1]);
      ob[e] = pk2(x2a * cs[2 * e] + x1a * sn[2 * e], x2b * cs[2 * e + 1] + x1b * sn[2 * e + 1]);
    }
    *(u32x4*)base = oa; *(u32x4*)(base + 32) = ob;
  }
}
DI int swap23(int p) { return (p & 3) | ((p & 4) << 1) | ((p & 8) >> 1); }
DI void prep_vt(const Ctx& c, const bf16_t* PB, bf16_t* Vt) {
  LAS unsigned char* T = c.lds;
  for (int u = c.bid; u < (M / 64) * 4; u += c.G) {
    const int tb = u >> 2, h = u & 3;
#pragma unroll
    for (int i = 0; i < 2; ++i) { const int idx = c.tid + 512 * i, r = idx >> 4, ch = idx & 15;
      const u32x4 v = *(const u32x4*)(PB + (size_t)(tb * 64 + r) * PB_W + 1024 + h * 128 + ch * 8);
      LAS unsigned* d = (LAS unsigned*)(T + r * 260 + ch * 16); d[0] = v.x; d[1] = v.y; d[2] = v.z; d[3] = v.w; }
    wg_sync();
#pragma unroll
    for (int i = 0; i < 2; ++i) { const int idx = c.tid + 512 * i, dv = idx >> 3, pc = idx & 7;
      unsigned w[4];
#pragma unroll
      for (int e = 0; e < 4; ++e) { const int p0 = 8 * pc + 2 * e, p1 = p0 + 1;
        const int k0 = (p0 & ~15) | swap23(p0 & 15), k1 = (p1 & ~15) | swap23(p1 & 15);
        const unsigned lo = *(const LAS unsigned short*)(T + k0 * 260 + dv * 2), hi = *(const LAS unsigned short*)(T + k1 * 260 + dv * 2);
        w[e] = lo | (hi << 16); }
      u32x4 o; o.x = w[0]; o.y = w[1]; o.z = w[2]; o.w = w[3];
      *(u32x4*)(Vt + ((size_t)(h * 128 + dv)) * M + tb * 64 + 8 * pc) = o; }
    wg_sync();
  }
}

DI float hgrn_lb(const float* lbw, int l, int j) {
  if (l == 0) return 0.f;
  const float a0 = lbw[j], a1 = lbw[256 + j]; const float mx = fmaxf(a0, a1), e0 = __expf(a0 - mx), e1 = __expf(a1 - mx);
  const float sm0 = e0 / (e0 + e1), sm1 = e1 / (e0 + e1); const float v = (sm0 + sm1) - sm0;
  return fminf(fmaxf(v, 0.f), 1.f);
}
template <bool PASSB>
DI void hgrn_pass(const Ctx& c, const float* PA, const float* lbw, int l, float* U, float* Dg, const float* Sin, const float* gng, bf16_t* MIX) {
  LAS float* F = (LAS float*)c.lds; LAS float* V = F + 8192; LAS float* Q = F + 16384;
  const int kseg = c.lane & 7, vv = c.lane >> 3, vcol = 8 * c.wave + vv;
  f32x4 rf[4], ri[4], rq[4]; float rS[8];
#define HG_LOAD_RAW(uu) do { const int ch_ = (uu) >> 2, h_ = (uu) & 3; \
    _Pragma("unroll") for (int i = 0; i < 4; ++i) { const int idx = c.tid + 512 * i, r = idx >> 4, c4 = idx & 15; const float* rowp = PA + (size_t)(ch_ * 128 + r) * PA_W + h_ * 64 + 4 * c4; \
      rf[i] = *(const f32x4*)(rowp + 256); ri[i] = *(const f32x4*)(rowp + 512); if (PASSB) rq[i] = *(const f32x4*)rowp; } \
    if (PASSB) { _Pragma("unroll") for (int j = 0; j < 8; ++j) rS[j] = Sin[(size_t)(uu) * 4096 + (8 * kseg + j) * 64 + vcol]; } } while (0)
  int u = c.bid;
  if (u < 512) HG_LOAD_RAW(u);
  while (u < 512) {
    const int ch = u >> 2, h = u & 3, t0 = ch * 128;
#pragma unroll
    for (int i = 0; i < 4; ++i) { const int idx = c.tid + 512 * i, r = idx >> 4, c4 = idx & 15; f32x4 f;
#pragma unroll
      for (int e = 0; e < 4; ++e) { const float lb = hgrn_lb(lbw, l, h * 64 + 4 * c4 + e); f[e] = lb + (1.f - lb) * sigmoidf_(rf[i][e]); }
      *(LAS f32x4*)(F + r * 64 + 4 * c4) = f; *(LAS f32x4*)(V + r * 64 + 4 * c4) = ri[i];
      if (PASSB) { f32x4 q;
#pragma unroll
        for (int e = 0; e < 4; ++e) q[e] = rq[i][e] * sigmoidf_(rq[i][e]);
        *(LAS f32x4*)(Q + r * 64 + 4 * c4) = q; } }
    float S[8];
#pragma unroll
    for (int j = 0; j < 8; ++j) S[j] = PASSB ? rS[j] : 0.f;
    wg_sync();
    const int un = u + c.G;
    if (un < 512) HG_LOAD_RAW(un);
    f32x4 fa_n = *(const LAS f32x4*)(F + 8 * kseg), fb_n = *(const LAS f32x4*)(F + 8 * kseg + 4); float v_n = V[vcol];
    f32x4 qa_n = {0.f, 0.f, 0.f, 0.f}, qb_n = qa_n;
    if (PASSB) { qa_n = *(const LAS f32x4*)(Q + 8 * kseg); qb_n = *(const LAS f32x4*)(Q + 8 * kseg + 4); }
#pragma unroll 4
    for (int t = 0; t < 128; ++t) {
      const f32x4 fa = fa_n, fb = fb_n, qa = qa_n, qb = qb_n; const float v1 = v_n;
      const int tn = (t + 1 < 128) ? t + 1 : 127;
      fa_n = *(const LAS f32x4*)(F + tn * 64 + 8 * kseg); fb_n = *(const LAS f32x4*)(F + tn * 64 + 8 * kseg + 4); v_n = V[tn * 64 + vcol];
      if (PASSB) { qa_n = *(const LAS f32x4*)(Q + tn * 64 + 8 * kseg); qb_n = *(const LAS f32x4*)(Q + tn * 64 + 8 * kseg + 4); }
#pragma unroll
      for (int j = 0; j < 4; ++j) { S[j] = fmaf(fa[j], S[j] - v1, v1); S[4 + j] = fmaf(fb[j], S[4 + j] - v1, v1); }
      if (PASSB) {
        float o = 0.f;
#pragma unroll
        for (int j = 0; j < 4; ++j) { o += qa[j] * S[j]; o += qb[j] * S[4 + j]; }
        o += dpp_xor1(o); o += dpp_xor2(o); o += dpp_hmirror(o);
        if (kseg == 0) V[t * 64 + vcol] = o;
      }
    }
    if (!PASSB) {
#pragma unroll
      for (int j = 0; j < 8; ++j) U[(size_t)u * 4096 + (8 * kseg + j) * 64 + vcol] = S[j];
      if (c.tid < 64) { float p = 1.f;
        for (int t = 0; t < 128; ++t) p *= F[t * 64 + c.tid];
        Dg[u * 64 + c.tid] = p; }
    } else {
      wg_sync();
      const int r = c.tid >> 2, sg = c.tid & 3;
      float o[16]; float ss = 0.f;
#pragma unroll
      for (int e = 0; e < 16; ++e) { o[e] = V[r * 64 + 16 * sg + e]; ss += o[e] * o[e]; }
      ss += dpp_xor1(ss); ss += dpp_xor2(ss);
      const float rstd = 1.f / sqrtf(ss * (1.f / 64.f) + EPS);
      const float* gp = PA + (size_t)(t0 + r) * PA_W + 768 + h * 64 + 16 * sg;
      unsigned w[8];
#pragma unroll
      for (int e = 0; e < 16; e += 2) { const float g0 = gp[e], g1 = gp[e + 1];
        const float a0 = o[e] * rstd * gng[16 * sg + e] * (g0 * sigmoidf_(g0)), a1 = o[e + 1] * rstd * gng[16 * sg + e + 1] * (g1 * sigmoidf_(g1));
        w[e >> 1] = pk2(a0, a1); }
      u32x4* op = (u32x4*)(MIX + (size_t)(t0 + r) * DM + h * 64 + 16 * sg);
      u32x4 w0, w1; w0.x = w[0]; w0.y = w[1]; w0.z = w[2]; w0.w = w[3]; w1.x = w[4]; w1.y = w[5]; w1.z = w[6]; w1.w = w[7];
      op[0] = w0; op[1] = w1;
    }
    wg_sync();
    u = un;
  }
#undef HG_LOAD_RAW
}
DI void hgrn_passA_mfma(const Ctx& c, const float* PA, const float* lbw, int l, float* U, float* Dg) {
  LAS float* F = (LAS float*)c.lds; LAS float* V = F + 8192;
  LAS unsigned char* KD = c.lds + 65536; LAS unsigned char* VT = c.lds + 65536 + 17408; LAS float* TS = (LAS float*)(c.lds + 65536 + 2 * 17408);
  const int kk = c.tid & 63, seg = c.tid >> 6;
  for (int u = c.bid; u < 512; u += c.G) {
    const int ch = u >> 2, h = u & 3, t0 = ch * 128;
#pragma unroll
    for (int i = 0; i < 4; ++i) { const int idx = c.tid + 512 * i, r = idx >> 4, c4 = idx & 15;
      const float* rowp = PA + (size_t)(t0 + r) * PA_W + h * 64 + 4 * c4;
      const f32x4 xf = *(const f32x4*)(rowp + 256), xi = *(const f32x4*)(rowp + 512); f32x4 f;
#pragma unroll
      for (int e = 0; e < 4; ++e) { const float lb = hgrn_lb(lbw, l, h * 64 + 4 * c4 + e); f[e] = lb + (1.f - lb) * sigmoidf_(xf[e]); }
      *(LAS f32x4*)(F + r * 64 + 4 * c4) = f; *(LAS f32x4*)(V + r * 64 + 4 * c4) = xi; }
    wg_sync();
    float fv[16], pl[16];
#pragma unroll
    for (int j = 0; j < 16; ++j) fv[j] = F[(seg * 16 + j) * 64 + kk];
    float p = 1.f;
#pragma unroll
    for (int j = 15; j >= 0; --j) { pl[j] = p; p *= fv[j]; }
    TS[seg * 64 + kk] = p;
    { unsigned w[8];
#pragma unroll
      for (int j = 0; j < 16; j += 2) w[j >> 1] = pk2(V[(seg * 16 + j) * 64 + kk], V[(seg * 16 + j + 1) * 64 + kk]);
      u32x4 w0, w1; w0.x = w[0]; w0.y = w[1]; w0.z = w[2]; w0.w = w[3]; w1.x = w[4]; w1.y = w[5]; w1.z = w[6]; w1.w = w[7];
      LAS u32x4* d = (LAS u32x4*)(VT + kk * 272 + seg * 32); d[0] = w0; d[1] = w1; }
    wg_sync();
    float suf = 1.f;
#pragma unroll
    for (int sg = 1; sg < 8; ++sg) { const float tsv = TS[sg * 64 + kk]; if (sg > seg) suf *= tsv; }
    if (seg == 0) Dg[u * 64 + kk] = p * suf;
    { unsigned w[8];
#pragma unroll
      for (int j = 0; j < 16; j += 2) w[j >> 1] = pk2((1.f - fv[j]) * pl[j] * suf, (1.f - fv[j + 1]) * pl[j + 1] * suf);
      u32x4 w0, w1; w0.x = w[0]; w0.y = w[1]; w0.z = w[2]; w0.w = w[3]; w1.x = w[4]; w1.y = w[5]; w1.z = w[6]; w1.w = w[7];
      LAS u32x4* d = (LAS u32x4*)(KD + kk * 272 + seg * 32); d[0] = w0; d[1] = w1; }
    wg_sync();
    { const int r16 = c.lane & 15, q4 = c.lane >> 4, mb = c.wave >> 1, nbp = c.wave & 1;
      f32x4 acc[2]; acc[0] = (f32x4){0.f, 0.f, 0.f, 0.f}; acc[1] = acc[0];
#pragma unroll
      for (int ks = 0; ks < 4; ++ks) { const bf16x8 af = *(const LAS bf16x8*)(KD + (16 * mb + r16) * 272 + (32 * ks + 8 * q4) * 2);
#pragma unroll
        for (int n2 = 0; n2 < 2; ++n2) { const bf16x8 bfv = *(const LAS bf16x8*)(VT + (16 * (2 * nbp + n2) + r16) * 272 + (32 * ks + 8 * q4) * 2);
          acc[n2] = __builtin_amdgcn_mfma_f32_16x16x32_bf16(af, bfv, acc[n2], 0, 0, 0); } }
      asm volatile("s_nop 7\n\ts_nop 7\n\ts_nop 7" :: "v"(acc[0]), "v"(acc[1]));
#pragma unroll
      for (int n2 = 0; n2 < 2; ++n2)
#pragma unroll
        for (int i = 0; i < 4; ++i) U[(size_t)u * 4096 + (16 * mb + 4 * q4 + i) * 64 + 16 * (2 * nbp + n2) + r16] = acc[n2][i]; }
    wg_sync();
  }
}
DI void hgrn_scan(const Ctx& c, const float* U, const float* Dg, float* Sin) {
  const int e = c.bid * 512 + c.tid, h = e >> 12, k = (e >> 6) & 63;
  float S = 0.f;
  for (int c0 = 0; c0 < 128; c0 += 32) {
    float uu[32], dd[32];
#pragma unroll
    for (int i = 0; i < 32; ++i) { uu[i] = U[(size_t)(c0 + i) * 16384 + e]; dd[i] = Dg[((c0 + i) * 4 + h) * 64 + k]; }
#pragma unroll
    for (int i = 0; i < 32; ++i) { Sin[(size_t)(c0 + i) * 16384 + e] = S; S = dd[i] * S + uu[i]; }
  }
}

struct S5Coef { float ar, ai; float Bre[16], Bim[16]; };
DI void s5_coef(CArgsP a, int l, int g, int p, S5Coef& k) {
  const int gp = (l * 16 + g) * 64 + p;
  const float lr = fminf(((const float*)a->in[6])[gp], -1e-4f), li = ((const float*)a->in[7])[gp], dt = __expf(((const float*)a->in[8])[gp]);
  const float er = __expf(lr * dt); float sn, cs; sincosf(li * dt, &sn, &cs);
  k.ar = er * cs; k.ai = er * sn;
  const float den = 1.f / (lr * lr + li * li), nr = k.ar - 1.f, ni = k.ai;
  const float sr = (nr * lr + ni * li) * den, si = (ni * lr - nr * li) * den;
  const float* bre = (const float*)a->in[9] + (size_t)gp * 16; const float* bim = (const float*)a->in[10] + (size_t)gp * 16;
#pragma unroll
  for (int h = 0; h < 16; ++h) { const float br = bre[h], bi = bim[h]; k.Bre[h] = br * sr - bi * si; k.Bim[h] = br * si + bi * sr; }
}
DI void s5_bu_tile(const LAS float* Ut, int sub, int g, const bf16x8 (&bfr)[8], LAS unsigned char* BUs, int lane) {
  const int r16 = lane & 15, q4 = lane >> 4;
  u32x4 aw = {0u, 0u, 0u, 0u};
  if (q4 < 2) { const LAS float* up = Ut + (16 * sub + r16) * 256 + 16 * g + 8 * q4; const f32x4 u0 = *(const LAS f32x4*)up, u1 = *(const LAS f32x4*)(up + 4);
    aw.x = pk2(u0.x, u0.y); aw.y = pk2(u0.z, u0.w); aw.z = pk2(u1.x, u1.y); aw.w = pk2(u1.z, u1.w); }
  const bf16x8 af = __builtin_bit_cast(bf16x8, aw);
  f32x4 acc[8];
#pragma unroll
  for (int nb = 0; nb < 8; ++nb) { const f32x4 z = {0.f, 0.f, 0.f, 0.f}; acc[nb] = __builtin_amdgcn_mfma_f32_16x16x32_bf16(af, bfr[nb], z, 0, 0, 0); }
  asm volatile("s_nop 7\n\ts_nop 7\n\ts_nop 7" :: "v"(aw.x), "v"(aw.y), "v"(aw.z), "v"(aw.w), "v"(acc[0]), "v"(acc[1]), "v"(acc[2]), "v"(acc[3]), "v"(acc[4]), "v"(acc[5]), "v"(acc[6]), "v"(acc[7]));
#pragma unroll
  for (int nb = 0; nb < 8; ++nb)
#pragma unroll
    for (int i = 0; i < 4; ++i) *(LAS float*)(BUs + (4 * q4 + i) * 528 + (16 * nb + r16) * 4) = acc[nb][i];
}
DI void s5_setup(CArgsP a, int l, int g, int lane, LAS unsigned char* tile, f32x2& ab, bf16x8 (&bfr)[8]) {
  S5Coef kc; s5_coef(a, l, g, lane, kc); ab.x = kc.ar; ab.y = kc.ai;
  u32x4 r0, r1, i0, i1;
  r0.x = pk2(kc.Bre[0], kc.Bre[1]); r0.y = pk2(kc.Bre[2], kc.Bre[3]); r0.z = pk2(kc.Bre[4], kc.Bre[5]); r0.w = pk2(kc.Bre[6], kc.Bre[7]);
  r1.x = pk2(kc.Bre[8], kc.Bre[9]); r1.y = pk2(kc.Bre[10], kc.Bre[11]); r1.z = pk2(kc.Bre[12], kc.Bre[13]); r1.w = pk2(kc.Bre[14], kc.Bre[15]);
  i0.x = pk2(kc.Bim[0], kc.Bim[1]); i0.y = pk2(kc.Bim[2], kc.Bim[3]); i0.z = pk2(kc.Bim[4], kc.Bim[5]); i0.w = pk2(kc.Bim[6], kc.Bim[7]);
  i1.x = pk2(kc.Bim[8], kc.Bim[9]); i1.y = pk2(kc.Bim[10], kc.Bim[11]); i1.z = pk2(kc.Bim[12], kc.Bim[13]); i1.w = pk2(kc.Bim[14], kc.Bim[15]);
  asm volatile("s_waitcnt lgkmcnt(0)" ::: "memory");
  LAS u32x4* st = (LAS u32x4*)(tile + lane * 64); st[0] = r0; st[1] = r1; st[2] = i0; st[3] = i1;
  asm volatile("s_waitcnt lgkmcnt(0)" ::: "memory");
  const int r16 = lane & 15, q4 = lane >> 4;
#pragma unroll
  for (int nb = 0; nb < 8; ++nb) { u32x4 w = {0u, 0u, 0u, 0u}; if (q4 < 2) w = *(const LAS u32x4*)(tile + (16 * nb + r16) * 32 + q4 * 16); bfr[nb] = __builtin_bit_cast(bf16x8, w); }
  asm volatile("s_waitcnt lgkmcnt(0)" ::: "memory");
}
DI void s5_load_u(const Ctx& c, const float* PA, int t0, LAS float* Ut) {
#pragma unroll
  for (int i = 0; i < 8; ++i) { const int idx = c.tid + 512 * i, r = idx >> 6, c4 = idx & 63;
    *(LAS f32x4*)(Ut + r * 256 + 4 * c4) = *(const f32x4*)(PA + (size_t)(t0 + r) * PA_W + 1024 + 4 * c4); }
}
DI void s5_step(const S5Coef& k, const LAS float* urow, float& xr, float& xi) {
  const f32x4 u0 = *(const LAS f32x4*)urow, u1 = *(const LAS f32x4*)(urow + 4), u2 = *(const LAS f32x4*)(urow + 8), u3 = *(const LAS f32x4*)(urow + 12);
  float br = 0.f, bi = 0.f;
#pragma unroll
  for (int e = 0; e < 4; ++e) { br += k.Bre[e] * u0[e]; bi += k.Bim[e] * u0[e]; br += k.Bre[4 + e] * u1[e]; bi += k.Bim[4 + e] * u1[e];
    br += k.Bre[8 + e] * u2[e]; bi += k.Bim[8 + e] * u2[e]; br += k.Bre[12 + e] * u3[e]; bi += k.Bim[12 + e] * u3[e]; }
  const float nr = k.ar * xr - k.ai * xi + br, ni = k.ar * xi + k.ai * xr + bi; xr = nr; xi = ni;
}
DI void s5_passA(const Ctx& c, CArgsP a, int l, const float* PA, f32x2* Xe) {
  LAS float* Ut = (LAS float*)c.lds; LAS unsigned char* BUs = c.lds + 65536 + c.wave * 8448;
  for (int u = c.bid; u < 256; u += c.G) {
    s5_load_u(c, PA, u * 64, Ut);
    wg_sync();
    for (int gi = 0; gi < 2; ++gi) { const int g = c.wave + 8 * gi;
      f32x2 ab; bf16x8 bfr[8]; s5_setup(a, l, g, c.lane, BUs, ab, bfr);
      float xr = 0.f, xi = 0.f;
      for (int sub = 0; sub < 4; ++sub) {
        asm volatile("" ::: "memory"); s5_bu_tile(Ut, sub, g, bfr, BUs, c.lane); asm volatile("" ::: "memory");
#pragma unroll 4
        for (int tt = 0; tt < 16; ++tt) { const LAS float* bp = (const LAS float*)(BUs + tt * 528 + 8 * c.lane); const float bur = bp[0], bui = bp[1];
          const float nr = ab.x * xr - ab.y * xi + bur, ni = ab.x * xi + ab.y * xr + bui; xr = nr; xi = ni; }
      }
      Xe[(size_t)(u * 16 + g) * 64 + c.lane] = (f32x2){xr, xi}; }
    wg_sync();
  }
}
DI void s5_scan(const Ctx& c, CArgsP a, int l, const f32x2* Xe, f32x2* Xin) {
  const int idx = (c.bid - 32) * 512 + c.tid;
  S5Coef k; s5_coef(a, l, idx >> 6, idx & 63, k);
  float pr = k.ar, pi = k.ai;
#pragma unroll
  for (int i = 0; i < 6; ++i) { const float nr = pr * pr - pi * pi, ni = 2.f * pr * pi; pr = nr; pi = ni; }
  float xr = 0.f, xi = 0.f;
  for (int c0 = 0; c0 < 256; c0 += 32) {
    f32x2 e[32];
#pragma unroll
    for (int i = 0; i < 32; ++i) e[i] = Xe[(size_t)(c0 + i) * 1024 + idx];
#pragma unroll
    for (int i = 0; i < 32; ++i) { Xin[(size_t)(c0 + i) * 1024 + idx] = (f32x2){xr, xi};
      const float nr = pr * xr - pi * xi + e[i].x, ni = pr * xi + pi * xr + e[i].y; xr = nr; xi = ni; }
  }
}
DI float gelu_tanh(float x) { const float u = 0.7978845608028654f * (x + 0.044715f * x * x * x); const float t = 1.f - 2.f / (1.f + __expf(2.f * u)); return 0.5f * x * (1.f + t); }
DI void s5_passB(const Ctx& c, CArgsP a, int l, const float* PA, const f32x2* Xin, const bf16_t* WgT, bf16_t* MIX) {
  LAS float* Ut = (LAS float*)c.lds;
  LAS unsigned char* XsB = c.lds + 65536 + c.wave * 8448;
  LAS unsigned char* Yb = c.lds + 65536;
  const float* cre = (const float*)a->in[11]; const float* cim = (const float*)a->in[12]; const float* dsk = (const float*)a->in[13];
  const float* ng = (const float*)a->in[15] + l * 256;
  for (int u = c.bid; u < 256; u += c.G) {
    const int t0 = u * 64;
    s5_load_u(c, PA, t0, Ut);
    wg_sync();
    for (int gi = 0; gi < 2; ++gi) { const int g = c.wave + 8 * gi;
      f32x2 ab; bf16x8 bfr[8]; s5_setup(a, l, g, c.lane, XsB, ab, bfr);
      const int hh = c.lane & 15, q4 = c.lane >> 4;
      bf16x8 cf[4];
#pragma unroll
      for (int ks = 0; ks < 4; ++ks) { const size_t ci = ((size_t)(l * 16 + g) * 16 + hh) * 64 + 16 * ks + 4 * q4;
        const f32x4 cr = *(const f32x4*)(cre + ci), cm = *(const f32x4*)(cim + ci); u32x4 w;
        w.x = pk2(cr.x, -cm.x); w.y = pk2(cr.y, -cm.y); w.z = pk2(cr.z, -cm.z); w.w = pk2(cr.w, -cm.w); cf[ks] = __builtin_bit_cast(bf16x8, w); }
      const float dh = dsk[(l * 16 + g) * 16 + hh];
      const f32x2 x0 = Xin[(size_t)(u * 16 + g) * 64 + c.lane]; float xr = x0.x, xi = x0.y;
      for (int sub = 0; sub < 4; ++sub) {
        asm volatile("" ::: "memory"); s5_bu_tile(Ut, sub, g, bfr, XsB, c.lane); asm volatile("" ::: "memory");
#pragma unroll 4
        for (int tt = 0; tt < 16; ++tt) { const LAS float* bp = (const LAS float*)(XsB + tt * 528 + 8 * c.lane); const float bur = bp[0], bui = bp[1];
          const float nr = ab.x * xr - ab.y * xi + bur, ni = ab.x * xi + ab.y * xr + bui; xr = nr; xi = ni;
          *(LAS float*)(XsB + tt * 528 + 4 * c.lane) = __uint_as_float(pk2(xr, xi)); }
        asm volatile("" ::: "memory");
        f32x4 acc = {0.f, 0.f, 0.f, 0.f};
#pragma unroll
        for (int ks = 0; ks < 4; ++ks) { const LAS float* ap = (const LAS float*)(XsB + hh * 528 + (32 * ks + 8 * q4) * 2); const f32x4 afv = {ap[0], ap[1], ap[2], ap[3]}; const bf16x8 af = __builtin_bit_cast(bf16x8, afv); acc = __builtin_amdgcn_mfma_f32_16x16x32_bf16(af, cf[ks], acc, 0, 0, 0); }
#pragma unroll
        for (int i = 0; i < 4; ++i) { LAS float* yp = Ut + (16 * sub + 4 * q4 + i) * 256 + 16 * g + hh; *yp = gelu_tanh(acc[i] + dh * (*yp)); }
      }
    }
    wg_sync();
#pragma unroll
    for (int i = 0; i < 8; ++i) { const int idx = c.tid + 512 * i, r = idx >> 6, c4 = idx & 63;
      const f32x4 v = *(const LAS f32x4*)(Ut + r * 256 + 4 * c4); u32x2 w; w.x = pk2(v.x, v.y); w.y = pk2(v.z, v.w);
      *(LAS u32x2*)(Yb + r * 528 + c4 * 8) = w; }
    wg_sync();
    {
      const int r16 = c.lane & 15, q4 = c.lane >> 4;
      f32x4 z[4][2];
#pragma unroll
      for (int m = 0; m < 4; ++m) { z[m][0] = (f32x4){0.f, 0.f, 0.f, 0.f}; z[m][1] = z[m][0]; }
#pragma unroll
      for (int ks = 0; ks < 8; ++ks) {
        bf16x8 bfr[2], afr[4];
#pragma unroll
        for (int n = 0; n < 2; ++n) bfr[n] = *(const bf16x8*)(WgT + (size_t)(32 * c.wave + 16 * n + r16) * 256 + 32 * ks + 8 * q4);
#pragma unroll
        for (int m = 0; m < 4; ++m) afr[m] = *(const LAS bf16x8*)(Yb + (16 * m + r16) * 528 + (32 * ks + 8 * q4) * 2);
#pragma unroll
        for (int m = 0; m < 4; ++m)
#pragma unroll
          for (int n = 0; n < 2; ++n) z[m][n] = __builtin_amdgcn_mfma_f32_16x16x32_bf16(afr[m], bfr[n], z[m][n], 0, 0, 0);
      }
#pragma unroll
      for (int m = 0; m < 4; ++m)
#pragma unroll
        for (int n = 0; n < 2; ++n)
#pragma unroll
          for (int e = 0; e < 4; ++e) { LAS float* yp = Ut + (16 * m + 4 * q4 + e) * 256 + 32 * c.wave + 16 * n + r16; const float y = *yp; *yp = y * sigmoidf_(z[m][n][e]); }
    }
    wg_sync();
    {
      const int r = c.tid >> 3, sg = c.tid & 7; float o[32]; float ss = 0.f;
#pragma unroll
      for (int e = 0; e < 32; e += 4) { const f32x4 v = *(const LAS f32x4*)(Ut + r * 256 + 32 * sg + e); o[e] = v.x; o[e + 1] = v.y; o[e + 2] = v.z; o[e + 3] = v.w;
        ss += (v.x * v.x + v.y * v.y) + (v.z * v.z + v.w * v.w); }
      ss += dpp_xor1(ss); ss += dpp_xor2(ss); ss += dpp_hmirror(ss);
      const float rstd = 1.f / sqrtf(ss * (1.f / 256.f) + EPS);
      u32x4* op = (u32x4*)(MIX + (size_t)(t0 + r) * DM + 256 + 32 * sg);
#pragma unroll
      for (int e = 0; e < 32; e += 8) { u32x4 w;
        w.x = pk2(o[e] * rstd * ng[32 * sg + e], o[e + 1] * rstd * ng[32 * sg + e + 1]); w.y = pk2(o[e + 2] * rstd * ng[32 * sg + e + 2], o[e + 3] * rstd * ng[32 * sg + e + 3]);
        w.z = pk2(o[e + 4] * rstd * ng[32 * sg + e + 4], o[e + 5] * rstd * ng[32 * sg + e + 5]); w.w = pk2(o[e + 6] * rstd * ng[32 * sg + e + 6], o[e + 7] * rstd * ng[32 * sg + e + 7]);
        op[e >> 3] = w; }
    }
    wg_sync();
  }
}
#define MFMA32(a, b, c) __builtin_amdgcn_mfma_f32_32x32x16_bf16((a), (b), (c), 0, 0, 0)
DI void attn_phase(const Ctx& c, CArgsP a, int l, const bf16_t* PB, const bf16_t* Vt, bf16_t* MIX) {
  const float* gq = (const float*)a->in[16] + l * 64; const float* gk = (const float*)a->in[17] + l * 64;
  const float s1 = wave_sum(((const float*)a->in[18])[l * 64 + c.lane] * ((const float*)a->in[19])[l * 64 + c.lane]);
  const float s2 = wave_sum(((const float*)a->in[20])[l * 64 + c.lane] * ((const float*)a->in[21])[l * 64 + c.lane]);
  const float lam_init = 0.8f - 0.6f * expf(-0.3f * (float)l), lam = expf(s1) - expf(s2) + lam_init;
  const float* sg = (const float*)a->in[22] + l * 128;
  const int comp = c.wave >> 2, wq = c.wave & 3, n = c.lane & 31, g = c.lane >> 5, sbit = my_stagger();
  const int rK = c.tid >> 3, cK = c.tid & 7;
  for (int u = c.bid; u < 512; u += c.G) {
    const int h = u & 3, jj = (u & 255) >> 2, qb = (u < 256) ? jj : 127 - jj;
    const int q0 = qb * 128 + wq * 32, nt = 2 * (qb + 1);
    bf16x8 qf[4];
#pragma unroll
    for (int ks = 0; ks < 4; ++ks) qf[ks] = *(const bf16x8*)(PB + (size_t)(q0 + n) * PB_W + (h * 2 + comp) * 64 + 16 * ks + 8 * g);
    f32x16 o[4];
#pragma unroll
    for (int mt = 0; mt < 4; ++mt)
#pragma unroll
      for (int i = 0; i < 16; ++i) o[mt][i] = 0.f;
    float lsum = 0.f;
    const int drow = 8 * c.wave + (c.lane >> 3), dch = (c.lane & 7) ^ ((drow >> 1) & 7);
    const unsigned voffK = (unsigned)(drow * PB_W + dch * 8) * 2u, voffV = (unsigned)(drow * M + dch * 8) * 2u;
    const char* gK = (const char*)(PB + 512 + (h * 2) * 64);
    const char* gV = (const char*)(Vt + (size_t)(h * 128) * M);
#define ATT_LOAD(kt) do { LAS unsigned char* b_ = c.lds + ((kt) & 3) * 32768 + c.wave * 1024; const char* kp_ = gK + (size_t)(kt) * (64 * PB_W * 2); const char* vp_ = gV + (size_t)(kt) * 128; \
      __builtin_amdgcn_global_load_lds((const unsigned*)(kp_ + voffK), (LAS unsigned*)b_, 16, 0, 0); __builtin_amdgcn_global_load_lds((const unsigned*)(kp_ + 128 + voffK), (LAS unsigned*)(b_ + 8192), 16, 0, 0); \
      __builtin_amdgcn_global_load_lds((const unsigned*)(vp_ + voffV), (LAS unsigned*)(b_ + 16384), 16, 0, 0); __builtin_amdgcn_global_load_lds((const unsigned*)(vp_ + (size_t)64 * M * 2 + voffV), (LAS unsigned*)(b_ + 24576), 16, 0, 0); } while (0)
#define ATT_STORE(sb) do { } while (0)
    f32x16 s[2]; bf16x8 pf[4];
    const f32x16 zero16 = {0.f, 0.f, 0.f, 0.f, 0.f, 0.f, 0.f, 0.f, 0.f, 0.f, 0.f, 0.f, 0.f, 0.f, 0.f, 0.f};
#define ATT_ACTIVE(j) (64 * (j) <= q0 + 31)
#define ATT_S(j, s) ATT_S_B(((j) & 3), s)
#define ATT_S_B(b, s) do { const LAS unsigned char* Kc = c.lds + (b) * 32768 + comp * 8192; \
      _Pragma("unroll") for (int ks = 0; ks < 4; ++ks) { bf16x8 kf[2]; _Pragma("unroll") for (int m = 0; m < 2; ++m) kf[m] = *(const LAS bf16x8*)(Kc + (32 * m + n) * 128 + (((2 * ks + g) ^ ((n >> 1) & 7)) * 16)); \
        _Pragma("unroll") for (int m = 0; m < 2; ++m) s[m] = (ks == 0) ? MFMA32(kf[m], qf[0], zero16) : MFMA32(kf[m], qf[ks], s[m]); } } while (0)
#define ATT_MASK(j, s) do { if (64 * (j) + 63 > q0) { const int qrow = q0 + n; \
        _Pragma("unroll") for (int m = 0; m < 2; ++m) _Pragma("unroll") for (int i = 0; i < 16; ++i) { const int key = 64 * (j) + 32 * m + (i & 3) + 8 * (i >> 2) + 4 * g; if (key > qrow) s[m][i] = -INFINITY; } } } while (0)
#define ATT_P(s) do { \
      _Pragma("unroll") for (int m = 0; m < 2; ++m) _Pragma("unroll") for (int i = 0; i < 16; ++i) { const float p = __builtin_amdgcn_exp2f(s[m][i]); s[m][i] = p; lsum += p; } \
      _Pragma("unroll") for (int kk = 0; kk < 4; ++kk) { const int m = kk >> 1, b = 8 * (kk & 1); u32x4 w; \
        w.x = pk2(s[m][b], s[m][b + 1]); w.y = pk2(s[m][b + 2], s[m][b + 3]); w.z = pk2(s[m][b + 4], s[m][b + 5]); w.w = pk2(s[m][b + 6], s[m][b + 7]); pf[kk] = __builtin_bit_cast(bf16x8, w); } } while (0)
#define ATT_V(j) ATT_V_B(((j) & 3))
#define ATT_V_B(b) do { const LAS unsigned char* Vs = c.lds + (b) * 32768 + 16384; \
      _Pragma("unroll") for (int kk = 0; kk < 4; ++kk) { bf16x8 vf[4]; _Pragma("unroll") for (int mt = 0; mt < 4; ++mt) vf[mt] = *(const LAS bf16x8*)(Vs + (32 * mt + n) * 128 + (((2 * kk + g) ^ ((n >> 1) & 7)) * 16)); \
        _Pragma("unroll") for (int mt = 0; mt < 4; ++mt) o[mt] = MFMA32(vf[mt], pf[kk], o[mt]); } } while (0)
    const __amdgpu_buffer_rsrc_t rsK = __builtin_amdgcn_make_buffer_rsrc((void*)gK, 0, 0x7fffffff, 0x00020000);
    const __amdgpu_buffer_rsrc_t rsV = __builtin_amdgcn_make_buffer_rsrc((void*)gV, 0, 0x7fffffff, 0x00020000);
#define ATT_LOADC(j) ATT_LOADC_B(j, ((j) & 3))
#define ATT_LOADC_B(j, b) do { const int jc_ = (j) < nt ? (j) : nt - 1; LAS unsigned char* b_ = c.lds + (b) * 32768 + c.wave * 1024; const unsigned sk_ = (unsigned)jc_ * (unsigned)(64 * PB_W * 2), sv_ = (unsigned)jc_ * 128u; \
      __builtin_amdgcn_raw_ptr_buffer_load_lds(rsK, (LAS unsigned*)b_, 16, voffK, sk_, 0, 0); __builtin_amdgcn_raw_ptr_buffer_load_lds(rsK, (LAS unsigned*)(b_ + 8192), 16, voffK, sk_ + 128u, 0, 0); \
      __builtin_amdgcn_raw_ptr_buffer_load_lds(rsV, (LAS unsigned*)(b_ + 16384), 16, voffV, sv_, 0, 0); __builtin_amdgcn_raw_ptr_buffer_load_lds(rsV, (LAS unsigned*)(b_ + 24576), 16, voffV, sv_ + (unsigned)(64 * M * 2), 0, 0); } while (0)
    ATT_LOADC(0); ATT_LOADC(1); ATT_LOADC(2);
    asm volatile("s_waitcnt vmcnt(4)\n\ts_barrier" ::: "memory");
    f32x16 s2[2];
    ATT_S(0, s);
    int kt = 0;
#define ATT_BAR4() asm volatile("s_waitcnt vmcnt(4) lgkmcnt(0)\n\ts_barrier" ::: "memory")
    for (; kt + 4 <= nt - 2; kt += 4) {
      ATT_S_B(1, s2); ATT_P(s);  ATT_LOADC_B(kt + 3, 3); ATT_V_B(0); ATT_BAR4();
      ATT_S_B(2, s);  ATT_P(s2); ATT_LOADC_B(kt + 4, 0); ATT_V_B(1); ATT_BAR4();
      ATT_S_B(3, s2); ATT_P(s);  ATT_LOADC_B(kt + 5, 1); ATT_V_B(2); ATT_BAR4();
      ATT_S_B(0, s);  ATT_P(s2); ATT_LOADC_B(kt + 6, 2); ATT_V_B(3); ATT_BAR4();
    }
    if (kt < nt - 2) {
      ATT_S_B(1, s2); ATT_P(s);  ATT_LOADC_B(kt + 3, 3); ATT_V_B(0); ATT_BAR4();
      ATT_S_B(2, s);  ATT_P(s2); ATT_LOADC_B(kt + 4, 0); ATT_V_B(1); ATT_BAR4();
      kt += 2;
    }
#undef ATT_BAR4
    ATT_MASK(kt, s);
    if (ATT_ACTIVE(kt + 1)) { ATT_S(kt + 1, s2); ATT_MASK(kt + 1, s2); }
    ATT_P(s); ATT_V(kt);
    asm volatile("s_waitcnt vmcnt(0) lgkmcnt(0)\n\ts_barrier" ::: "memory");
    if (ATT_ACTIVE(kt + 1)) { ATT_P(s2); ATT_V(kt + 1); }
    asm volatile("s_waitcnt vmcnt(0) lgkmcnt(0)\n\ts_barrier" ::: "memory");
#undef ATT_MASK
#undef ATT_LOADC
#undef ATT_ACTIVE
#undef ATT_S
#undef ATT_P
#undef ATT_V
#undef ATT_LOAD
#undef ATT_STORE
    lsum += __shfl_xor(lsum, 32);
    const float inv = 1.f / lsum;
    LAS float* X = (LAS float*)c.lds; const int row = wq * 32 + n;
    if (comp == 1) {
#pragma unroll
      for (int mt = 0; mt < 4; ++mt)
#pragma unroll
        for (int i4 = 0; i4 < 4; ++i4) { f32x4 v = {o[mt][4 * i4] * inv, o[mt][4 * i4 + 1] * inv, o[mt][4 * i4 + 2] * inv, o[mt][4 * i4 + 3] * inv};
          *(LAS f32x4*)(X + row * 132 + 32 * mt + 8 * i4 + 4 * g) = v; }
    }
    wg_sync();
    if (comp == 0) {
      float ssq = 0.f;
#pragma unroll
      for (int mt = 0; mt < 4; ++mt)
#pragma unroll
        for (int i4 = 0; i4 < 4; ++i4) { const f32x4 x1 = *(const LAS f32x4*)(X + row * 132 + 32 * mt + 8 * i4 + 4 * g);
#pragma unroll
          for (int e = 0; e < 4; ++e) { const float d = o[mt][4 * i4 + e] * inv - lam * x1[e]; o[mt][4 * i4 + e] = d; ssq += d * d; } }
      ssq += __shfl_xor(ssq, 32);
      const float rstd = (1.f - lam_init) / sqrtf(ssq * (1.f / 128.f) + EPS);
      const float* sgp = sg; asm volatile("" : "+s"(sgp));
#pragma unroll
      for (int mt = 0; mt < 4; ++mt)
#pragma unroll
        for (int i4 = 0; i4 < 4; ++i4) { const int dv = 32 * mt + 8 * i4 + 4 * g; const f32x4 gg = *(const f32x4*)(sgp + dv);
          f32x4 v = {o[mt][4 * i4] * rstd * gg.x, o[mt][4 * i4 + 1] * rstd * gg.y, o[mt][4 * i4 + 2] * rstd * gg.z, o[mt][4 * i4 + 3] * rstd * gg.w};
          *(LAS f32x4*)(X + row * 132 + dv) = v; }
    }
    wg_sync();
    {
      const int r = c.tid >> 2, sgm = c.tid & 3;
      u32x4* op = (u32x4*)(MIX + (size_t)(qb * 128 + r) * DM + 512 + h * 128 + 32 * sgm);
#pragma unroll
      for (int e = 0; e < 4; ++e) { const f32x4 v0 = *(const LAS f32x4*)(X + r * 132 + 32 * sgm + 8 * e), v1 = *(const LAS f32x4*)(X + r * 132 + 32 * sgm + 8 * e + 4);
        u32x4 w; w.x = pk2(v0.x, v0.y); w.y = pk2(v0.z, v0.w); w.z = pk2(v1.x, v1.y); w.w = pk2(v1.z, v1.w); op[e] = w; }
    }
    wg_sync();
  }
}

__global__ void __launch_bounds__(512, 2) hymba_fwd(Args a_unused) {
  extern __shared__ __attribute__((aligned(16))) unsigned char lds_raw[];
  LAS unsigned char* lds = (LAS unsigned char*)lds_raw;
  __shared__ uint4 xb_words;
  if (threadIdx.x == 0) xb_words = make_uint4(0u, 0u, 0u, 0u);
  if (threadIdx.x < 4) g_simdcnt[threadIdx.x] = 0u;
  __syncthreads();
  if ((threadIdx.x & 63) == 0) { const unsigned r = atomicAdd(&g_simdcnt[(hw_slot() >> 4) & 3u], 1u); g_wtab[hw_slot()] = (threadIdx.x >> 6) | ((r & 1u) << 8); }
  __syncthreads();
  { CArgsP a = get_args(); if (blockIdx.x == 0) { unsigned* bw = (unsigned*)(a->ws + WS_BAR); for (int i = threadIdx.x; i < XCD_BAR_WORDS; i += 512) bw[i] = 0u; } }
#define WSP(T, off) ((T*)(a->ws + (off)))
  if (PH & 1) { CArgsP a = get_args(); Ctx c = mk_ctx(lds); prologue_weights(c, a); convert_rows(c, (const float*)a->in[0], WSP(bf16_t, WS_XN), WSP(u64_t, WS_SSQ));
    for (int i = c.bid * 512 + c.tid; i < 3 * M; i += c.G * 512) WSP(u64_t, WS_SSQ)[M + i] = 0ull;
    rope_table(c, (const int*)a->in[1], WSP(f32x2, WS_ROPE)); }
  cg::this_grid().sync();
  { CArgsP a = get_args(); (void)xcd_barrier_post((unsigned*)(a->ws + WS_BAR), (volatile LAS unsigned*)&xb_words); }
#define GBAR() do { CArgsP a_ = get_args(); XcdBarrier b_; b_.bar = (unsigned*)(a_->ws + WS_BAR); b_.x = xb_xcc_id(); b_.st = (volatile LAS unsigned*)&xb_words; xcd_barrier(b_); } while (0)
#pragma unroll 1
  for (int l = 0; l < DEPTH; ++l) {
    if (PH & 2) { CArgsP a = get_args(); Ctx c = mk_ctx(lds); unsigned char* wb = a->ws + WS_W + (size_t)l * LAYER_W;
      pg8::Gemm g{WSP(bf16_t, WS_XN), (const bf16_t*)(wb + W_IN_OFF), M, NIN, DM}; pg8::StaticOrder S; S.init(M, NIN, c.G, c.bid); pg8::EpiInProj E{WSP(float, WS_PA), WSP(bf16_t, WS_PB), WSP(u64_t, WS_SSQ) + (size_t)(2 * l) * M};
      pg8::gemm_phase<pg8::EpiInProj, pg8::StaticOrder, true, true>(c.lds, g, S, E); }
    GBAR();
    if (PH & 16) { CArgsP a = get_args(); Ctx c = mk_ctx(lds); hgrn_passA_mfma(c, WSP(float, WS_PA), (const float*)a->in[2], l, WSP(float, WS_HU), WSP(float, WS_HD)); }
    if (PH & 32) { CArgsP a = get_args(); Ctx c = mk_ctx(lds); s5_passA(c, a, l, WSP(float, WS_PA), WSP(f32x2, WS_XE)); }
    GBAR();
    if (PH & 64) { CArgsP a = get_args(); Ctx c = mk_ctx(lds);
      if (c.bid < 32) hgrn_scan(c, WSP(float, WS_HU), WSP(float, WS_HD), WSP(float, WS_HSIN)); else if (c.bid < 34) s5_scan(c, a, l, WSP(f32x2, WS_XE), WSP(f32x2, WS_XIN)); }
    if (PH & 4) { CArgsP a = get_args(); Ctx c = mk_ctx(lds); if (c.bid >= 34) { c.bid -= 34; c.G -= 34; prep_qk(c, WSP(bf16_t, WS_PB), WSP(f32x2, WS_ROPE), (const float*)a->in[16] + l * 64, (const float*)a->in[17] + l * 64); } }
    if (PH & 8) { CArgsP a = get_args(); Ctx c = mk_ctx(lds); if (c.bid >= 34) { c.bid -= 34; c.G -= 34; prep_vt(c, WSP(bf16_t, WS_PB), WSP(bf16_t, WS_VT)); } }
    GBAR();
    if (PH & 128) { CArgsP a = get_args(); Ctx c = mk_ctx(lds); attn_phase(c, a, l, WSP(bf16_t, WS_PB), WSP(bf16_t, WS_VT), WSP(bf16_t, WS_MIX)); }
    if (PH & 256) { CArgsP a = get_args(); Ctx c = mk_ctx(lds); hgrn_pass<true>(c, WSP(float, WS_PA), (const float*)a->in[2], l, nullptr, nullptr, WSP(float, WS_HSIN), (const float*)a->in[5] + l * 64, WSP(bf16_t, WS_MIX)); }
    if (PH & 512) { CArgsP a = get_args(); Ctx c = mk_ctx(lds); unsigned char* wb = a->ws + WS_W + (size_t)l * LAYER_W; s5_passB(c, a, l, WSP(float, WS_PA), WSP(f32x2, WS_XIN), (const bf16_t*)(wb + W_GLU_OFF), WSP(bf16_t, WS_MIX)); }
    GBAR();
    if (PH & 1024) { CArgsP a = get_args(); Ctx c = mk_ctx(lds); unsigned char* wb = a->ws + WS_W + (size_t)l * LAYER_W; const float* xin = (l == 0) ? (const float*)a->in[0] : (const float*)a->out;
      pg8::Gemm g{WSP(bf16_t, WS_MIX), (const bf16_t*)(wb + W_OUT_OFF), M, DM, DM}; pg8::StaticOrder S; S.init(M, DM, c.G, c.bid); pg8::EpiRes E{xin, a->out, WSP(bf16_t, WS_XN), WSP(u64_t, WS_SSQ) + (size_t)(2 * l + 1) * M};
      pg8::gemm_phase<pg8::EpiRes, pg8::StaticOrder, false, true>(c.lds, g, S, E); }
    GBAR();
    if (PH & 2048) { CArgsP a = get_args(); Ctx c = mk_ctx(lds); unsigned char* wb = a->ws + WS_W + (size_t)l * LAYER_W;
      pg8::Gemm g{WSP(bf16_t, WS_XN), (const bf16_t*)(wb + W_UP_OFF), M, DFF, DM}; pg8::StaticOrder S; S.init(M, DFF, c.G, c.bid); pg8::EpiRelu2 E{WSP(bf16_t, WS_H), WSP(u64_t, WS_SSQ) + (size_t)(2 * l + 1) * M};
      pg8::gemm_phase<pg8::EpiRelu2, pg8::StaticOrder, true, true>(c.lds, g, S, E); }
    GBAR();
    if (PH & 4096) { CArgsP a = get_args(); Ctx c = mk_ctx(lds); unsigned char* wb = a->ws + WS_W + (size_t)l * LAYER_W;
      pg8::Gemm g{WSP(bf16_t, WS_H), (const bf16_t*)(wb + W_DOWN_OFF), M, DM, DFF}; pg8::StaticOrder S; S.init(M, DM, c.G, c.bid); pg8::EpiRes E{a->out, a->out, (l + 1 < DEPTH) ? WSP(bf16_t, WS_XN) : (bf16_t*)nullptr, WSP(u64_t, WS_SSQ) + (size_t)(2 * l + 2 < 4 ? 2 * l + 2 : 0) * M};
      pg8::gemm_phase<pg8::EpiRes, pg8::StaticOrder, false, true>(c.lds, g, S, E); }
    GBAR();
  }
#undef WSP
}

extern "C" void kernel_launch(void* const* d_in, const int* in_sizes, int n_in, void* d_out, int out_size, void* d_ws, size_t ws_size, hipStream_t stream) {
  static int grid = 0; constexpr int LDSB = 65536 + 8 * 8448;
  if (grid == 0) {
    int dev = 0, cus = 0, per = 0;
    if (hipGetDevice(&dev) != hipSuccess || hipDeviceGetAttribute(&cus, hipDeviceAttributeMultiprocessorCount, dev) != hipSuccess) { fprintf(stderr, "device query failed\n"); grid = -1; return; }
    if (hipFuncSetAttribute((const void*)hymba_fwd, hipFuncAttributeMaxDynamicSharedMemorySize, LDSB) != hipSuccess) { fprintf(stderr, "hipFuncSetAttribute failed\n"); grid = -1; return; }
    if (hipOccupancyMaxActiveBlocksPerMultiprocessor(&per, (const void*)hymba_fwd, 512, LDSB) != hipSuccess || per < 1) fprintf(stderr, "occupancy query: %d\n", per);
    (void)hipGetLastError();
    grid = cus;
    if (n_in != 27 || ws_size < 256 * MiB) fprintf(stderr, "unexpected n_in %d / ws_size %zu\n", n_in, ws_size);
  }
  if (grid < 0) return;
  Args a{};
  for (int i = 0; i < 27; ++i) a.in[i] = d_in[i];
  a.out = (float*)d_out; a.ws = (unsigned char*)d_ws;
  void* args[] = {&a};
  hipError_t e = hipLaunchCooperativeKernel((const void*)hymba_fwd, dim3(grid), dim3(512), args, LDSB, stream);
  if (e != hipSuccess) fprintf(stderr, "cooperative launch failed: %s (grid %d)\n", hipGetErrorString(e), grid);
}
```
